# Optimizing an MI355X kernel written in HIP

```python
import math
import jax, jax.numpy as jnp
from jax import lax
import numpy as np

D_MODEL = 2048
BATCH = 2
SEQ = 16384
DEPTH = 2

CHUNK = 64
LEFT_CHUNKS = 8
BAND = LEFT_CHUNKS + 1

MIX_WIDTH = D_MODEL
ATTN_WIDTH = MIX_WIDTH // 2
POOL_WIDTH = MIX_WIDTH - ATTN_WIDTH
HEAD_DIM = 128
N_HEADS = ATTN_WIDTH // HEAD_DIM
REL_CLIP = 128
POOL_WINDOWS = (2, 4, 8, 16)
N_POOL_GROUPS = len(POOL_WINDOWS)
POOL_GROUP = POOL_WIDTH // N_POOL_GROUPS
IN_WIDTH = 3 * ATTN_WIDTH + POOL_WIDTH

D_FF = 5632
CONV_WIDTH = 3
NORM_EPS = 1e-6

kernel_name = "hybrid_chunked_attn_multiscale_pool_convffn"


def rms_norm(x, g):
    xf = x.astype(jnp.float32)
    y = xf * lax.rsqrt(jnp.mean(xf * xf, axis=-1, keepdims=True) + NORM_EPS)
    return (y * g.astype(jnp.float32)).astype(x.dtype)


def _band_bias_index():
    q_pos = np.arange(CHUNK) + LEFT_CHUNKS * CHUNK
    k_pos = np.arange(BAND * CHUNK)
    rel = np.clip(q_pos[:, None] - k_pos[None, :], -REL_CLIP, REL_CLIP)
    return (rel + REL_CLIP).astype(np.int32)


def chunked_attention(q, k, v, rel_bias):
    B, S, H, Dh = q.shape
    N = S // CHUNK
    qc = q.reshape(B, N, CHUNK, H, Dh)
    pad = ((0, 0), (LEFT_CHUNKS * CHUNK, 0), (0, 0), (0, 0))
    kc = jnp.pad(k, pad).reshape(B, N + LEFT_CHUNKS, CHUNK, H, Dh)
    vc = jnp.pad(v, pad).reshape(B, N + LEFT_CHUNKS, CHUNK, H, Dh)
    scale = 1.0 / math.sqrt(Dh)
    scores = jnp.concatenate(
        [jnp.einsum('bnqhd,bnkhd->bnhqk', qc, kc[:, j:j + N],
                    preferred_element_type=jnp.float32) for j in range(BAND)],
        axis=-1) * scale
    bias = rel_bias.astype(jnp.float32)[:, _band_bias_index()]
    scores = scores + bias[None, None]
    key_chunk = np.repeat(np.arange(BAND), CHUNK)
    valid = (jnp.arange(N)[:, None] + key_chunk[None, :]) >= LEFT_CHUNKS
    scores = jnp.where(valid[None, :, None, None, :], scores, jnp.float32(-1e30))
    probs = jax.nn.softmax(scores, axis=-1).astype(v.dtype)
    out = 0.0
    for j in range(BAND):
        out = out + jnp.einsum('bnhqk,bnkhd->bnqhd',
                               probs[..., j * CHUNK:(j + 1) * CHUNK], vc[:, j:j + N])
    return out.reshape(B, S, H, Dh)


def multiscale_pool(u, pool_w, pool_scale):
    B, S, _ = u.shape
    uf = u.astype(jnp.float32)
    cs = jnp.cumsum(uf, axis=1)
    pos_count = jnp.arange(1, S + 1, dtype=jnp.float32)
    groups = []
    for g, w in enumerate(POOL_WINDOWS):
        sl = slice(g * POOL_GROUP, (g + 1) * POOL_GROUP)
        csg = cs[..., sl]
        shifted = jnp.pad(csg, ((0, 0), (w, 0), (0, 0)))[:, :S]
        count = jnp.minimum(pos_count, jnp.float32(w))[None, :, None]
        groups.append((csg - shifted) / count - uf[..., sl])
    pooled = jnp.stack(groups, axis=2).astype(u.dtype)
    mixed = jnp.einsum('bsgc,gcd->bsgd', pooled, pool_w).reshape(B, S, POOL_WIDTH)
    return mixed * pool_scale


def causal_dwconv(u, conv_w, conv_b):
    S = u.shape[1]
    up = jnp.pad(u, ((0, 0), (CONV_WIDTH - 1, 0), (0, 0)))
    out = conv_b
    for t in range(CONV_WIDTH):
        out = out + up[:, t:t + S] * conv_w[t]
    return out


def setup_inputs(seed: int = 0) -> dict:
    key = jax.random.key(seed)
    ks = jax.random.split(key, 16)
    f32 = jnp.float32
    nrm = lambda k, shape, s: jax.random.normal(k, shape, f32) * s
    gain = lambda k, n: 1.0 + 0.02 * jax.random.normal(k, (DEPTH, n), f32)
    return {
        "x": nrm(ks[0], (BATCH, SEQ, D_MODEL), 1.0),
        "pre_mix_g": gain(ks[1], D_MODEL),
        "w_in": nrm(ks[2], (DEPTH, D_MODEL, IN_WIDTH), D_MODEL ** -0.5),
        "rel_bias": nrm(ks[3], (DEPTH, N_HEADS, 2 * REL_CLIP + 1), 0.1),
        "pool_w": nrm(ks[4], (DEPTH, N_POOL_GROUPS, POOL_GROUP, POOL_GROUP), POOL_GROUP ** -0.5),
        "pool_scale": gain(ks[5], POOL_WIDTH),
        "w_o": nrm(ks[6], (DEPTH, MIX_WIDTH, D_MODEL), MIX_WIDTH ** -0.5),
        "post_mix_g": gain(ks[7], D_MODEL),
        "pre_ffn_g": gain(ks[8], D_MODEL),
        "w_up": nrm(ks[9], (DEPTH, D_MODEL, 2 * D_FF), D_MODEL ** -0.5),
        "conv_w": nrm(ks[10], (DEPTH, CONV_WIDTH, 2 * D_FF), CONV_WIDTH ** -0.5),
        "conv_b": nrm(ks[11], (DEPTH, 2 * D_FF), 0.01),
        "w_down": nrm(ks[12], (DEPTH, D_FF, D_MODEL), D_FF ** -0.5),
        "post_ffn_g": gain(ks[13], D_MODEL),
    }


def reference(x, pre_mix_g, w_in, rel_bias, pool_w, pool_scale, w_o, post_mix_g,
              pre_ffn_g, w_up, conv_w, conv_b, w_down, post_ffn_g):
    B, S, _ = x.shape
    for l in range(DEPTH):
        h = rms_norm(x, pre_mix_g[l])
        z = h @ w_in[l]
        q = z[..., :ATTN_WIDTH].reshape(B, S, N_HEADS, HEAD_DIM)
        k = z[..., ATTN_WIDTH:2 * ATTN_WIDTH].reshape(B, S, N_HEADS, HEAD_DIM)
        v = z[..., 2 * ATTN_WIDTH:3 * ATTN_WIDTH].reshape(B, S, N_HEADS, HEAD_DIM)
        u = z[..., 3 * ATTN_WIDTH:]
        a = chunked_attention(q, k, v, rel_bias[l]).reshape(B, S, ATTN_WIDTH)
        p = multiscale_pool(u, pool_w[l], pool_scale[l])
        m = jnp.concatenate([a, p], axis=-1) @ w_o[l]
        x = x + rms_norm(m, post_mix_g[l])
        h = rms_norm(x, pre_ffn_g[l])
        up = causal_dwconv(h @ w_up[l], conv_w[l], conv_b[l])
        y = (jax.nn.gelu(up[..., :D_FF], approximate=True) * up[..., D_FF:]) @ w_down[l]
        x = x + rms_norm(y, post_ffn_g[l])
    return x
```

```cpp
#include <hip/hip_runtime.h>
#include <hip/hip_cooperative_groups.h>
#include <cstdio>
#include <cstdint>
namespace cg = cooperative_groups;

#ifndef MK_COOP
#define MK_COOP 0
#endif

#define LAS __attribute__((address_space(3)))
typedef unsigned short bf16_t;
typedef short bf16x8 __attribute__((ext_vector_type(8)));
typedef float f32x4 __attribute__((ext_vector_type(4)));
typedef float f32x2 __attribute__((ext_vector_type(2)));
typedef unsigned u32x4 __attribute__((ext_vector_type(4)));
typedef unsigned u32x2 __attribute__((ext_vector_type(2)));

constexpr int BATCH = 2, SEQ = 16384, T = BATCH * SEQ, DM = 2048, DEPTH = 2;
constexpr int NH = 8, HD = 128, AW = 1024, PWD = 1024, FF = 5632, FF2 = 11264, INW = 4096, NQKU = 3072;
constexpr int NREL = 257;
constexpr float NORM_EPS = 1e-6f;
constexpr float LOG2E = 1.4426950408889634f;

__device__ __forceinline__ unsigned cvt_pk_bf16(float lo, float hi) { unsigned r; asm volatile("v_cvt_pk_bf16_f32 %0, %1, %2" : "=v"(r) : "v"(lo), "v"(hi)); return r; }
__device__ __forceinline__ float bf_lo(unsigned w) { return __uint_as_float(w << 16); }
__device__ __forceinline__ float bf_hi(unsigned w) { return __uint_as_float(w & 0xffff0000u); }

namespace pg8 {
constexpr int BM = 256, BK = 64, HALF = 128, HTB = HALF * BK * 2, STAGE_BYTES = 8 * HTB, NXCD = 8, WGM = 8;

__host__ __device__ __forceinline__ int lds_byte(int r, int c) { const int st = (r >> 4) * 2 + (c >> 5), rr = r & 15, cc = c & 31, ob = rr * 64 + cc * 2; return st * 1024 + (ob ^ (((ob >> 9) & 1) << 5)); }
__host__ __device__ __forceinline__ void stage_rc(int b, int& R, int& C) { const int st = b / 1024, sb = b % 1024, swz = sb ^ (((sb >> 9) & 1) << 5); R = (st >> 1) * 16 + swz / 64; C = (st & 1) * 32 + (swz % 64) / 2; }
__host__ __device__ __forceinline__ int perm32(int rho) { const int n = rho >> 4, i = rho & 15; return 8 * (i >> 2) + 4 * n + (i & 3); }

struct Unit { int pm, pn; };
struct Gemm { const bf16_t* A; const bf16_t* Bt; int K, lda, ldb, a_col_per_pn; };

struct StaticOrder {
    int nM, nN, nwg, G, c;
    __host__ __device__ void init(int M, int N, int G_, int c_) { nM = M / BM; nN = N / BM; nwg = nM * nN; G = G_; c = c_; }
    __host__ __device__ bool next(int i, Unit& u) const {
        const long L = (long)i * G + c; if (L >= nwg) return false;
        int wgid = (int)L; { const int q = nwg / NXCD, r = nwg % NXCD, xcd = wgid % NXCD, off = wgid / NXCD; wgid = (xcd < r ? xcd * (q + 1) : r * (q + 1) + (xcd - r) * q) + off; }
        const int nig = WGM * nN, gid = wgid / nig, fm = gid * WGM, gsz = (nM - fm) < WGM ? (nM - fm) : WGM;
        u.pm = fm + ((wgid % nig) % gsz); u.pn = (wgid % nig) / gsz; return true;
    }
};

struct EpiStore {
    static constexpr bool PERM = true;
    bf16_t* O; int ldc; int col_off; const float* colscale;
    __device__ __forceinline__ void operator()(const f32x4 (&acc)[2][2][4][2], const Unit& u, int wr, int wc, int fr, int fq) const {
        const int row0 = u.pm * BM + wr * 64 + fr; const int col0 = u.pn * BM + wc * 32 + 8 * fq;
        f32x4 sv[2][2];
#pragma unroll
        for (int bj = 0; bj < 2; ++bj)
#pragma unroll
            for (int n = 0; n < 2; ++n) sv[bj][n] = colscale ? *(const f32x4*)(colscale + col0 + bj * HALF + 4 * n) : (f32x4){1.f, 1.f, 1.f, 1.f};
#pragma unroll
        for (int ai = 0; ai < 2; ++ai)
#pragma unroll
            for (int m = 0; m < 4; ++m) { bf16_t* rowp = O + (size_t)(row0 + ai * HALF + m * 16) * ldc + col_off + col0;
#pragma unroll
                for (int bj = 0; bj < 2; ++bj) { f32x4 v0 = acc[ai][bj][m][0] * sv[bj][0], v1 = acc[ai][bj][m][1] * sv[bj][1];
                    u32x4 w; w.x = cvt_pk_bf16(v0[0], v0[1]); w.y = cvt_pk_bf16(v0[2], v0[3]); w.z = cvt_pk_bf16(v1[0], v1[1]); w.w = cvt_pk_bf16(v1[2], v1[3]);
                    *(u32x4*)(rowp + bj * HALF) = w; } }
    }
};

#define DPPF(old, src, ctrl) __builtin_bit_cast(float, __builtin_amdgcn_update_dpp(__builtin_bit_cast(int, (float)(old)), __builtin_bit_cast(int, (float)(src)), (ctrl), 0xf, 0xf, false))
__device__ __forceinline__ float gelu_tanh(float x) {
    const float u = x * (1.0f + 0.044715f * x * x);
    const float e = __builtin_amdgcn_exp2f(-2.3022081985f * u);
    return x * __builtin_amdgcn_rcpf(1.0f + e);
}
struct EpiUpConv {
    static constexpr bool PERM = true;
    bf16_t* G; const float* cw; const float* cb; float* halo; LAS unsigned char* xl;
    __device__ __forceinline__ void operator()(const f32x4 (&acc)[2][2][4][2], const Unit& u, int wr, int wc, int fr, int fq) const {
        LAS f32x4* X = (LAS f32x4*)xl;
        const int colg = u.pn * 128 + wc * 32 + 8 * fq;
        if (fr >= 14) {
#pragma unroll
            for (int ai = 0; ai < 2; ++ai)
#pragma unroll
                for (int bj = 0; bj < 2; ++bj)
#pragma unroll
                    for (int n = 0; n < 2; ++n) X[(((((ai * 2 + wr) * 4 + wc) * 2 + bj) * 2 + n) * 2 + (fr - 14)) * 4 + fq] = acc[ai][bj][3][n];
            if (wr == 1) {
#pragma unroll
                for (int bj = 0; bj < 2; ++bj)
#pragma unroll
                    for (int n = 0; n < 2; ++n) *(f32x4*)(halo + ((size_t)u.pm * 4 + 2 + (fr - 14)) * FF2 + bj * FF + colg + 4 * n) = acc[1][bj][3][n];
            }
        }
        if (wr == 0 && fr < 2) {
#pragma unroll
            for (int bj = 0; bj < 2; ++bj)
#pragma unroll
                for (int n = 0; n < 2; ++n) *(f32x4*)(halo + ((size_t)u.pm * 4 + fr) * FF2 + bj * FF + colg + 4 * n) = acc[0][bj][0][n];
        }
        asm volatile("s_waitcnt lgkmcnt(0)" ::: "memory"); __builtin_amdgcn_s_barrier(); asm volatile("" ::: "memory");
#pragma unroll
        for (int n = 0; n < 2; ++n) {
            f32x4 w0[2], w1[2], w2[2], bb[2];
#pragma unroll
            for (int bj = 0; bj < 2; ++bj) { const int oc = bj * FF + colg + 4 * n;
                w0[bj] = *(const f32x4*)(cw + oc); w1[bj] = *(const f32x4*)(cw + FF2 + oc); w2[bj] = *(const f32x4*)(cw + 2 * FF2 + oc); bb[bj] = *(const f32x4*)(cb + oc); }
#pragma unroll
            for (int ai = 0; ai < 2; ++ai) {
                const int seg = ai * 2 + wr;
                f32x4 vp[2];
#pragma unroll
                for (int bj = 0; bj < 2; ++bj) { vp[bj] = (f32x4){0.f, 0.f, 0.f, 0.f};
                    if (seg > 0 && fr >= 14) vp[bj] = X[((((((seg - 1) * 4 + wc) * 2 + bj) * 2 + n) * 2 + (fr - 14)) * 4) + fq]; }
#pragma unroll
                for (int m = 0; m < 4; ++m) {
                    f32x4 cv[2];
#pragma unroll
                    for (int bj = 0; bj < 2; ++bj) { const f32x4 cur = acc[ai][bj][m][n]; const f32x4 prv = (m == 0) ? vp[bj] : acc[ai][bj][m == 0 ? 0 : m - 1][n];
#pragma unroll
                        for (int j = 0; j < 4; ++j) { const float t1 = DPPF(0.f, prv[j], 0x121), p1 = DPPF(t1, cur[j], 0x111); const float t2 = DPPF(0.f, prv[j], 0x122), p2 = DPPF(t2, cur[j], 0x112);
                            cv[bj][j] = bb[bj][j] + w0[bj][j] * p2 + w1[bj][j] * p1 + w2[bj][j] * cur[j]; } }
                    f32x4 o;
#pragma unroll
                    for (int j = 0; j < 4; ++j) o[j] = gelu_tanh(cv[0][j]) * cv[1][j];
                    u32x2 w; w.x = cvt_pk_bf16(o[0], o[1]); w.y = cvt_pk_bf16(o[2], o[3]);
                    *(u32x2*)(G + (size_t)(u.pm * BM + ai * HALF + wr * 64 + m * 16 + fr) * FF + colg + 4 * n) = w;
                }
            }
        }
    }
};

template <class Epi, class Sched, bool ALIGN_EPI = false>
__device__ __forceinline__ void gemm_phase(LAS unsigned char* lds, const Gemm g, const Sched& S, const Epi& E) {
    int tid_ = threadIdx.x; asm volatile("" : "+v"(tid_));
    const int tid = tid_, wid = __builtin_amdgcn_readfirstlane(tid >> 6), lane = tid & 63, wr = wid >> 2, wc = wid & 3, fr = lane & 15, fq = lane >> 4;
    const int K = g.K, nt = K / BK;
    unsigned voffA[2], voffB[2];
#pragma unroll
    for (int i = 0; i < 2; ++i) { int R, C; stage_rc(tid * 16 + i * 8192, R, C); const int Rb = Epi::PERM ? ((R & ~31) + perm32(R & 31)) : R;
        voffA[i] = (unsigned)(R * g.lda + C) * 2u; voffB[i] = (unsigned)(Rb * g.ldb + C) * 2u; }
    const size_t kstep = (size_t)(BK * 2);
    const size_t hstepA = (size_t)HALF * g.lda * 2, hstepB = (size_t)HALF * g.ldb * 2;
    const unsigned ldsw = (unsigned)wid * 1024u;
    const int aoff = lds_byte(wr * 64 + fr, fq * 8), boff = lds_byte(wc * 32 + fr, fq * 8);
#define PG8_SA(b, h) (((b) * 2 + (h)) * HTB)
#define PG8_SB(b, h) ((4 + (b) * 2 + (h)) * HTB)
#define PG8_STAGE(bufoff, gbase, voff) do { _Pragma("unroll") for (int _i = 0; _i < 2; ++_i) \
        __builtin_amdgcn_global_load_lds((const unsigned*)((const char*)(gbase) + (voff)[_i]), (LAS unsigned*)(lds + (bufoff) + ldsw + _i * 8192), 16, 0, 0); } while (0)
#define PG8_LDA(dst, b, h) do { _Pragma("unroll") for (int m = 0; m < 4; ++m) _Pragma("unroll") for (int k = 0; k < 2; ++k) dst[m][k] = *(const LAS bf16x8*)(lds + PG8_SA(b, h) + aoff + m * 2048 + k * 1024); } while (0)
#define PG8_LDB(dst, b, h) do { _Pragma("unroll") for (int n = 0; n < 2; ++n) _Pragma("unroll") for (int k = 0; k < 2; ++k) dst[n][k] = *(const LAS bf16x8*)(lds + PG8_SB(b, h) + boff + n * 2048 + k * 1024); } while (0)
#define PG8_MMA(ai, bj, At, Bt) do { __builtin_amdgcn_s_setprio(1); _Pragma("unroll") for (int m = 0; m < 4; ++m) _Pragma("unroll") for (int n = 0; n < 2; ++n) _Pragma("unroll") for (int k = 0; k < 2; ++k) \
        acc[ai][bj][m][n] = __builtin_amdgcn_mfma_f32_16x16x32_bf16(Bt[n][k], At[m][k], acc[ai][bj][m][n], 0, 0, 0); __builtin_amdgcn_s_setprio(0); } while (0)
#define PG8_WAIT_V(n) asm volatile("s_waitcnt vmcnt(" #n ")" ::: "memory")
#define PG8_WAIT_L(n) asm volatile("s_waitcnt lgkmcnt(" #n ")" ::: "memory")
#define PG8_BAR __builtin_amdgcn_s_barrier()
#define PG8_SCHED __builtin_amdgcn_sched_barrier(0)
#define PG8_UA(u) ((const char*)g.A + (size_t)(u).pm * 2 * hstepA + (size_t)(u).pn * (size_t)g.a_col_per_pn * 2)
#define PG8_UB(u) ((const char*)g.Bt + (size_t)(u).pn * 2 * hstepB)
    Unit cur, nxt; int ui = 0;
    if (!S.next(0, cur)) return;
    f32x4 acc[2][2][4][2];
#pragma unroll
    for (int a = 0; a < 2; ++a)
#pragma unroll
        for (int b = 0; b < 2; ++b)
#pragma unroll
            for (int m = 0; m < 4; ++m)
#pragma unroll
                for (int n = 0; n < 2; ++n) acc[a][b][m][n] = (f32x4){0.f, 0.f, 0.f, 0.f};
    bf16x8 At[4][2], B0[2][2], B1[2][2];
    const char* cA = PG8_UA(cur); const char* cB = PG8_UB(cur);
    PG8_STAGE(PG8_SB(0, 0), cB, voffB); PG8_STAGE(PG8_SB(0, 1), cB + hstepB, voffB); PG8_STAGE(PG8_SA(0, 0), cA, voffA); PG8_STAGE(PG8_SA(0, 1), cA + hstepA, voffA);
    if (wr == 1) PG8_BAR;
    PG8_WAIT_V(2); PG8_BAR;
    PG8_STAGE(PG8_SB(1, 0), cB + kstep, voffB); PG8_STAGE(PG8_SA(1, 0), cA + kstep, voffA); PG8_STAGE(PG8_SB(1, 1), cB + hstepB + kstep, voffB);
    PG8_WAIT_V(6); PG8_BAR;
    for (;;) {
        const bool has_next = S.next(ui + 1, nxt);
        const char* nA = has_next ? PG8_UA(nxt) : cA; const char* nB = has_next ? PG8_UB(nxt) : cB;
        for (int t = 0; t < nt; t += 2) {
            const bool last = (t == nt - 2);
            const char* a1 = cA + (size_t)(t + 1) * kstep;
            const char* a2 = last ? nA : cA + (size_t)(t + 2) * kstep; const char* b2 = last ? nB : cB + (size_t)(t + 2) * kstep;
            const char* a3 = a2 + kstep; const char* b3 = b2 + kstep;
            PG8_LDB(B0, 0, 0); PG8_LDB(B1, 0, 1); PG8_SCHED; PG8_LDA(At, 0, 0); PG8_STAGE(PG8_SA(1, 1), a1 + hstepA, voffA);
            PG8_WAIT_V(8); PG8_WAIT_L(0); PG8_BAR; PG8_MMA(0, 0, At, B0); PG8_MMA(0, 1, At, B1); PG8_BAR; PG8_SCHED;
            PG8_LDA(At, 0, 1); PG8_STAGE(PG8_SB(0, 0), b2, voffB); PG8_STAGE(PG8_SB(0, 1), b2 + hstepB, voffB); PG8_STAGE(PG8_SA(0, 0), a2, voffA);
            PG8_WAIT_V(8); PG8_WAIT_L(0); PG8_BAR; PG8_MMA(1, 0, At, B0); PG8_MMA(1, 1, At, B1); PG8_BAR; PG8_SCHED;
            PG8_LDB(B0, 1, 0); PG8_LDB(B1, 1, 1); PG8_SCHED; PG8_LDA(At, 1, 0); PG8_STAGE(PG8_SA(0, 1), a2 + hstepA, voffA);
            PG8_WAIT_V(8); PG8_WAIT_L(0); PG8_BAR; PG8_MMA(0, 0, At, B0); PG8_MMA(0, 1, At, B1); PG8_BAR; PG8_SCHED;
            PG8_LDA(At, 1, 1); PG8_STAGE(PG8_SB(1, 0), b3, voffB); PG8_STAGE(PG8_SB(1, 1), b3 + hstepB, voffB); PG8_STAGE(PG8_SA(1, 0), a3, voffA);
            PG8_WAIT_V(8); PG8_WAIT_L(0); PG8_BAR; PG8_MMA(1, 0, At, B0); PG8_MMA(1, 1, At, B1); PG8_BAR; PG8_SCHED;
        }
        if constexpr (ALIGN_EPI) { if (wr == 0) PG8_BAR; }
        E(acc, cur, wr, wc, fr, fq);
        if (!has_next) break;
#pragma unroll
        for (int a = 0; a < 2; ++a)
#pragma unroll
            for (int b = 0; b < 2; ++b)
#pragma unroll
                for (int m = 0; m < 4; ++m)
#pragma unroll
                    for (int n = 0; n < 2; ++n) acc[a][b][m][n] = (f32x4){0.f, 0.f, 0.f, 0.f};
        cur = nxt; cA = nA; cB = nB; ++ui;
        if constexpr (ALIGN_EPI) { if (wr == 1) PG8_BAR; }
    }
    PG8_WAIT_V(0);
    if constexpr (!ALIGN_EPI) { if (wr == 0) PG8_BAR; }
    PG8_BAR;
#undef PG8_SA
#undef PG8_SB
#undef PG8_STAGE
#undef PG8_LDA
#undef PG8_LDB
#undef PG8_MMA
#undef PG8_WAIT_V
#undef PG8_WAIT_L
#undef PG8_BAR
#undef PG8_SCHED
#undef PG8_UA
#undef PG8_UB
}
}

constexpr size_t MiB = 1u << 20;
constexpr size_t WS_W = 1 * MiB, W_LAYER = 91 * MiB;
constexpr size_t WO_IN = 0, WO_O = 16 * MiB, WO_UP = 24 * MiB, WO_DOWN = 68 * MiB, WO_POOL = 90 * MiB;
constexpr size_t WS_H = 183 * MiB;
constexpr size_t WS_QKU = 311 * MiB, WS_VT = 503 * MiB, WS_CC = 567 * MiB;
constexpr size_t WS_G = 311 * MiB;
constexpr size_t WS_POOLED = 695 * MiB;
constexpr size_t WS_MY = 759 * MiB;
constexpr size_t WS_HALO = 887 * MiB;
constexpr size_t WS_END = 909 * MiB;

constexpr int RING_BYTES = 131072, XCH_OFF = RING_BYTES, LDS_BYTES = 147456;

struct Args {
    const float* x; const float* pre_mix_g; const float* w_in; const float* rel_bias; const float* pool_w; const float* pool_scale; const float* w_o;
    const float* post_mix_g; const float* pre_ffn_g; const float* w_up; const float* conv_w; const float* conv_b; const float* w_down; const float* post_ffn_g;
    float* out; unsigned char* ws; int ph_lo, ph_hi, coop, pad;
};

__device__ __forceinline__ float wave_sum(float v) {
#pragma unroll
    for (int o = 1; o < 64; o <<= 1) v += __shfl_xor(v, o);
    return v;
}
__device__ __forceinline__ unsigned f2bf(float f) { unsigned u = __builtin_bit_cast(unsigned, f); return (u + 0x7fffu + ((u >> 16) & 1u)) >> 16; }
__device__ __forceinline__ unsigned pk2(float lo, float hi) { return f2bf(lo) | (f2bf(hi) << 16); }

__device__ __forceinline__ void transpose_item(const float* W, int N, bf16_t* WT, int ldk, int k0, int n0, int drow0, LAS float* scr, int lane) {
#pragma unroll 8
    for (int i = 0; i < 32; ++i) { const int kk = 2 * i + (lane >> 5); scr[kk * 33 + (lane & 31)] = W[(size_t)(k0 + kk) * N + n0 + (lane & 31)]; }
    asm volatile("s_waitcnt lgkmcnt(0)" ::: "memory");
    const int c = lane & 7;
#pragma unroll
    for (int j = 0; j < 4; ++j) { const int n = (lane >> 3) + 8 * j; const LAS float* s = scr + (8 * c) * 33 + n;
        u32x4 o; o.x = pk2(s[0 * 33], s[1 * 33]); o.y = pk2(s[2 * 33], s[3 * 33]); o.z = pk2(s[4 * 33], s[5 * 33]); o.w = pk2(s[6 * 33], s[7 * 33]);
        *(u32x4*)(WT + (size_t)(drow0 + n) * ldk + k0 + 8 * c) = o; }
    asm volatile("s_waitcnt lgkmcnt(0)" ::: "memory");
}

__device__ __forceinline__ void rms_row_to_bf16(const float* xrow, const float* g, bf16_t* orow, int lane) {
    f32x4 v[8]; float s = 0.f;
#pragma unroll
    for (int j = 0; j < 4; ++j) { v[2 * j] = *(const f32x4*)(xrow + 8 * (lane + 64 * j)); v[2 * j + 1] = *(const f32x4*)(xrow + 8 * (lane + 64 * j) + 4); }
#pragma unroll
    for (int j = 0; j < 8; ++j) s += (v[j].x * v[j].x + v[j].y * v[j].y) + (v[j].z * v[j].z + v[j].w * v[j].w);
    const float rstd = 1.0f / sqrtf(wave_sum(s) * (1.0f / DM) + NORM_EPS);
#pragma unroll
    for (int j = 0; j < 4; ++j) { const int c = 8 * (lane + 64 * j); const f32x4 g0 = *(const f32x4*)(g + c), g1 = *(const f32x4*)(g + c + 4); const f32x4 a = v[2 * j] * rstd * g0, b = v[2 * j + 1] * rstd * g1;
        u32x4 w; w.x = cvt_pk_bf16(a.x, a.y); w.y = cvt_pk_bf16(a.z, a.w); w.z = cvt_pk_bf16(b.x, b.y); w.w = cvt_pk_bf16(b.z, b.w); *(u32x4*)(orow + c) = w; }
}

__device__ __forceinline__ void res_norm_row(const bf16_t* mrow, const float* xin, float* xout, const float* g1, const float* g2, bf16_t* hrow, int lane) {
    f32x4 v[8]; float s = 0.f;
#pragma unroll
    for (int j = 0; j < 4; ++j) { const u32x4 w = *(const u32x4*)(mrow + 8 * (lane + 64 * j));
        v[2 * j] = (f32x4){bf_lo(w.x), bf_hi(w.x), bf_lo(w.y), bf_hi(w.y)}; v[2 * j + 1] = (f32x4){bf_lo(w.z), bf_hi(w.z), bf_lo(w.w), bf_hi(w.w)}; }
#pragma unroll
    for (int j = 0; j < 8; ++j) s += (v[j].x * v[j].x + v[j].y * v[j].y) + (v[j].z * v[j].z + v[j].w * v[j].w);
    const float rstd = 1.0f / sqrtf(wave_sum(s) * (1.0f / DM) + NORM_EPS);
    float s2 = 0.f;
#pragma unroll
    for (int j = 0; j < 8; ++j) { const int c = 8 * (lane + 64 * (j >> 1)) + 4 * (j & 1); const f32x4 gg = *(const f32x4*)(g1 + c); const f32x4 xi = *(const f32x4*)(xin + c);
        v[j] = xi + v[j] * rstd * gg; *(f32x4*)(xout + c) = v[j]; s2 += (v[j].x * v[j].x + v[j].y * v[j].y) + (v[j].z * v[j].z + v[j].w * v[j].w); }
    if (hrow) {
        const float rstd2 = 1.0f / sqrtf(wave_sum(s2) * (1.0f / DM) + NORM_EPS);
#pragma unroll
        for (int j = 0; j < 4; ++j) { const int c = 8 * (lane + 64 * j); const f32x4 g0 = *(const f32x4*)(g2 + c), g1v = *(const f32x4*)(g2 + c + 4); const f32x4 a = v[2 * j] * rstd2 * g0, b = v[2 * j + 1] * rstd2 * g1v;
            u32x4 w; w.x = cvt_pk_bf16(a.x, a.y); w.y = cvt_pk_bf16(a.z, a.w); w.z = cvt_pk_bf16(b.x, b.y); w.w = cvt_pk_bf16(b.z, b.w); *(u32x4*)(hrow + c) = w; }
    }
}

constexpr int AT_BT = 0, AT_BUF = 8448, AT_KSTR = 272, AT_VSTR = 144, AT_VOFF = 64 * AT_KSTR, AT_BUFSZ = AT_VOFF + 128 * AT_VSTR;
static_assert(AT_BUF + 2 * AT_BUFSZ <= RING_BYTES, "attention LDS");
__device__ __forceinline__ void attn_phase(LAS unsigned char* lds, const bf16_t* QKU, const bf16_t* VT, bf16_t* CC, const float* relb, int vcu, int G) {
    int tid_ = threadIdx.x; asm volatile("" : "+v"(tid_));
    const int tid = tid_, wid = __builtin_amdgcn_readfirstlane(tid >> 6), lane = tid & 63, fr = lane & 15, fq = lane >> 4;
    LAS float* bt = (LAS float*)(lds + AT_BT);
    for (int i = tid; i < NH * NREL; i += 512) bt[(i / NREL) * 260 + (i % NREL)] = relb[i] * LOG2E;
    __syncthreads();
    const float SC = 0.08838834764831845f * LOG2E;
    for (int unit = vcu; unit < BATCH * NH * 128; unit += G) {
        const int bh = unit >> 7, np = unit & 127, b = bh >> 3, h = bh & 7;
        const int qc = 2 * np + (wid >> 2), ql = (wid & 3) * 16 + fr;
        const size_t trow = (size_t)b * SEQ + qc * 64 + ql;
        bf16x8 Qf[4];
#pragma unroll
        for (int ds = 0; ds < 4; ++ds) Qf[ds] = *(const bf16x8*)(QKU + trow * NQKU + h * HD + 32 * ds + 8 * fq);
        const int kc_lo = (2 * np - 8) > 0 ? (2 * np - 8) : 0, kc_hi = 2 * np + 1;
        const int my_lo = (qc - 8) > 0 ? (qc - 8) : 0, my_hi = qc;
        f32x4 O[8];
#pragma unroll
        for (int d = 0; d < 8; ++d) O[d] = (f32x4){0.f, 0.f, 0.f, 0.f};
        float mrun = -1e30f, lrun = 0.f;
        const LAS float* bth = bt + h * 260;
        const int kr0 = tid >> 4, kc16 = tid & 15, vr0 = tid >> 3, vc16 = tid & 7;
        const bf16_t* ksrc = QKU + ((size_t)b * SEQ + kr0) * NQKU + AW + h * HD + kc16 * 8;
        const bf16_t* vsrc = VT + (size_t)(h * HD + vr0) * T + (size_t)b * SEQ + vc16 * 8;
        const int kdst = kr0 * AT_KSTR + kc16 * 16, vdst = AT_VOFF + vr0 * AT_VSTR + vc16 * 16;
        u32x4 kreg[2], vreg[2];
#define AT_LOAD(kc) do { kreg[0] = *(const u32x4*)(ksrc + (size_t)(kc) * 64 * NQKU); kreg[1] = *(const u32x4*)(ksrc + ((size_t)(kc) * 64 + 32) * NQKU); \
                         vreg[0] = *(const u32x4*)(vsrc + (size_t)(kc) * 64); vreg[1] = *(const u32x4*)(vsrc + (size_t)64 * T + (size_t)(kc) * 64); } while (0)
#define AT_STORE(buf) do { LAS unsigned char* bb_ = lds + AT_BUF + (buf) * AT_BUFSZ; *(LAS u32x4*)(bb_ + kdst) = kreg[0]; *(LAS u32x4*)(bb_ + kdst + 32 * AT_KSTR) = kreg[1]; \
                           *(LAS u32x4*)(bb_ + vdst) = vreg[0]; *(LAS u32x4*)(bb_ + vdst + 64 * AT_VSTR) = vreg[1]; } while (0)
        AT_LOAD(kc_lo); AT_STORE(0);
        __syncthreads();
        for (int kc = kc_lo; kc <= kc_hi; ++kc) {
            const int cur = (kc - kc_lo) & 1;
            if (kc < kc_hi) AT_LOAD(kc + 1);
            if (kc >= my_lo && kc <= my_hi) {
                const LAS unsigned char* Kb = lds + AT_BUF + cur * AT_BUFSZ; const LAS unsigned char* Vb = Kb + AT_VOFF;
                f32x4 s[4];
#pragma unroll
                for (int kb = 0; kb < 4; ++kb) { s[kb] = (f32x4){0.f, 0.f, 0.f, 0.f};
                    const int krow = 32 * (kb >> 1) + 8 * (fr >> 2) + 4 * (kb & 1) + (fr & 3);
#pragma unroll
                    for (int ds = 0; ds < 4; ++ds) { const bf16x8 kf = *(const LAS bf16x8*)(Kb + krow * AT_KSTR + (32 * ds + 8 * fq) * 2);
                        s[kb] = __builtin_amdgcn_mfma_f32_16x16x32_bf16(kf, Qf[ds], s[kb], 0, 0, 0); } }
                const int dch = qc - kc;
                if (dch >= 3) { const float cbias = bth[256];
#pragma unroll
                    for (int kb = 0; kb < 4; ++kb) s[kb] = s[kb] * SC + cbias;
                } else {
                    const int rb = 64 * dch + ql - 8 * fq + 128;
#pragma unroll
                    for (int kb = 0; kb < 4; ++kb)
#pragma unroll
                        for (int j = 0; j < 4; ++j) { int idx = rb - (32 * (kb >> 1) + 4 * (kb & 1) + j); idx = idx > 256 ? 256 : idx; s[kb][j] = s[kb][j] * SC + bth[idx]; }
                }
                float mx = s[0][0];
#pragma unroll
                for (int kb = 0; kb < 4; ++kb)
#pragma unroll
                    for (int j = 0; j < 4; ++j) mx = fmaxf(mx, s[kb][j]);
                mx = fmaxf(mx, __shfl_xor(mx, 16)); mx = fmaxf(mx, __shfl_xor(mx, 32));
                const float mnew = fmaxf(mrun, mx), alpha = __builtin_amdgcn_exp2f(mrun - mnew); mrun = mnew;
                float ps = 0.f;
#pragma unroll
                for (int kb = 0; kb < 4; ++kb)
#pragma unroll
                    for (int j = 0; j < 4; ++j) { s[kb][j] = __builtin_amdgcn_exp2f(s[kb][j] - mnew); ps += s[kb][j]; }
                lrun = lrun * alpha + ps;
#pragma unroll
                for (int d = 0; d < 8; ++d) O[d] = O[d] * alpha;
                bf16x8 Pf[2];
#pragma unroll
                for (int ks = 0; ks < 2; ++ks) { u32x4 w; w.x = cvt_pk_bf16(s[2 * ks][0], s[2 * ks][1]); w.y = cvt_pk_bf16(s[2 * ks][2], s[2 * ks][3]);
                    w.z = cvt_pk_bf16(s[2 * ks + 1][0], s[2 * ks + 1][1]); w.w = cvt_pk_bf16(s[2 * ks + 1][2], s[2 * ks + 1][3]); Pf[ks] = __builtin_bit_cast(bf16x8, w); }
#pragma unroll
                for (int d = 0; d < 8; ++d)
#pragma unroll
                    for (int ks = 0; ks < 2; ++ks) { const bf16x8 vf = *(const LAS bf16x8*)(Vb + (16 * d + fr) * AT_VSTR + (32 * ks + 8 * fq) * 2);
                        O[d] = __builtin_amdgcn_mfma_f32_16x16x32_bf16(vf, Pf[ks], O[d], 0, 0, 0); }
            }
            if (kc < kc_hi) AT_STORE(cur ^ 1);
            __syncthreads();
        }
#undef AT_LOAD
#undef AT_STORE
        float lt = lrun; lt += __shfl_xor(lt, 16); lt += __shfl_xor(lt, 32);
        const float inv = 1.0f / lt;
        bf16_t* op = CC + trow * DM + h * HD + 4 * fq;
#pragma unroll
        for (int d = 0; d < 8; ++d) { const f32x4 o = O[d] * inv; u32x2 w; w.x = cvt_pk_bf16(o[0], o[1]); w.y = cvt_pk_bf16(o[2], o[3]); *(u32x2*)(op + 16 * d) = w; }
    }
}

constexpr int N_PHASES = 1 + 9 * DEPTH;
__global__ void __launch_bounds__(512, 2) fwd_megakernel(Args a) {
    extern __shared__ __attribute__((aligned(16))) unsigned char lds_raw[];
    LAS unsigned char* lds = (LAS unsigned char*)lds_raw;
    const int wave = __builtin_amdgcn_readfirstlane((int)threadIdx.x >> 6);
    const int G = gridDim.x, bx = blockIdx.x;
#define OPAQUE_TID() int tid = threadIdx.x; asm volatile("" : "+v"(tid)); const int lane = tid & 63; (void)lane
    const int vcu = (G % 8 == 0) ? (bx % 8) * (G / 8) + bx / 8 : bx;
    const int gw = vcu * 8 + wave, NGW = G * 8;
    unsigned char* ws = a.ws;
    bf16_t* Hb = (bf16_t*)(ws + WS_H); bf16_t* QKU = (bf16_t*)(ws + WS_QKU); bf16_t* VT = (bf16_t*)(ws + WS_VT); bf16_t* CC = (bf16_t*)(ws + WS_CC);
    bf16_t* Gb = (bf16_t*)(ws + WS_G); bf16_t* PL = (bf16_t*)(ws + WS_POOLED); bf16_t* MY = (bf16_t*)(ws + WS_MY); float* HALO = (float*)(ws + WS_HALO);
    const int lo = a.ph_lo, hi = a.ph_hi;
    int ph = 0;
#define IN_PH() (lo <= ph && ph < hi)
#define END_PH() do { ++ph; if (a.coop && lo < ph && ph < hi) cg::this_grid().sync(); } while (0)

    if (IN_PH()) {
        OPAQUE_TID();
        LAS float* scr = (LAS float*)(lds + wave * 16384);
        constexpr int I_IN = (DM / 64) * (INW / 32), I_O = (DM / 64) * (DM / 32), I_UP = (DM / 64) * (FF2 / 32), I_DN = (FF / 64) * (DM / 32), I_PL = 4 * (256 / 64) * (256 / 32);
        constexpr int I_LAYER = I_IN + I_O + I_UP + I_DN + I_PL;
        for (int it = gw; it < DEPTH * I_LAYER; it += NGW) {
            const int l = it / I_LAYER; int r = it % I_LAYER;
            unsigned char* wl = ws + WS_W + (size_t)l * W_LAYER;
            if (r < I_IN) { const int nblk = INW / 32, kb = r / nblk, nb = r % nblk, n0 = 32 * nb;
                const int drow = n0 < 2048 ? n0 : (n0 < 3072 ? n0 + 1024 : n0 - 1024);
                transpose_item(a.w_in + (size_t)l * DM * INW, INW, (bf16_t*)(wl + WO_IN), DM, 64 * kb, n0, drow, scr, lane); continue; } r -= I_IN;
            if (r < I_O) { const int nblk = DM / 32, kb = r / nblk, nb = r % nblk;
                transpose_item(a.w_o + (size_t)l * DM * DM, DM, (bf16_t*)(wl + WO_O), DM, 64 * kb, 32 * nb, 32 * nb, scr, lane); continue; } r -= I_O;
            if (r < I_UP) { const int nblk = FF2 / 32, kb = r / nblk, nb = r % nblk, n0 = 32 * nb;
                const int half = n0 >= FF ? 1 : 0, cc = n0 - half * FF; const int drow = 256 * (cc >> 7) + 128 * half + (cc & 127);
                transpose_item(a.w_up + (size_t)l * DM * FF2, FF2, (bf16_t*)(wl + WO_UP), DM, 64 * kb, n0, drow, scr, lane); continue; } r -= I_UP;
            if (r < I_DN) { const int nblk = DM / 32, kb = r / nblk, nb = r % nblk;
                transpose_item(a.w_down + (size_t)l * FF * DM, DM, (bf16_t*)(wl + WO_DOWN), FF, 64 * kb, 32 * nb, 32 * nb, scr, lane); continue; } r -= I_DN;
            { const int gidx = r / 32, rr = r % 32, kb = rr / 8, nb = rr % 8;
                transpose_item(a.pool_w + ((size_t)l * 4 + gidx) * 65536, 256, (bf16_t*)(wl + WO_POOL) + (size_t)gidx * 65536, 256, 64 * kb, 32 * nb, 32 * nb, scr, lane); }
        }
        for (int m = gw; m < T; m += NGW) rms_row_to_bf16(a.x + (size_t)m * DM, a.pre_mix_g, Hb + (size_t)m * DM, lane);
    }
    END_PH();

    for (int l = 0; l < DEPTH; ++l) {
        unsigned char* wl = ws + WS_W + (size_t)l * W_LAYER;
        const bf16_t* Win = (const bf16_t*)(wl + WO_IN); const bf16_t* Wo = (const bf16_t*)(wl + WO_O); const bf16_t* Wup = (const bf16_t*)(wl + WO_UP);
        const bf16_t* Wdn = (const bf16_t*)(wl + WO_DOWN); const bf16_t* Wpl = (const bf16_t*)(wl + WO_POOL);
        if (IN_PH()) {
            { pg8::Gemm g{Hb, Win, DM, DM, DM, 0}; pg8::StaticOrder S; S.init(T, NQKU, G, bx); pg8::EpiStore E{QKU, NQKU, 0, nullptr};
              pg8::gemm_phase<pg8::EpiStore, pg8::StaticOrder, true>(lds, g, S, E); }
            { pg8::Gemm g{Win + (size_t)NQKU * DM, Hb, DM, DM, DM, 0}; pg8::StaticOrder S; S.init(AW, T, G, bx); pg8::EpiStore E{VT, T, 0, nullptr};
              pg8::gemm_phase<pg8::EpiStore, pg8::StaticOrder, true>(lds, g, S, E); }
        }
        END_PH();
        if (IN_PH()) {
            attn_phase(lds, QKU, VT, CC, a.rel_bias + (size_t)l * NH * NREL, vcu, G);
            OPAQUE_TID();
            for (int item = bx * 512 + tid; item < (T / 32) * 128; item += G * 512) {
                const int cv = item & 127, tb = item >> 7; const int c0 = cv * 8, grp = cv >> 5, w = 2 << grp;
                const int r0 = tb * 32, s0 = r0 % SEQ;
                const bf16_t* up = QKU + 2048 + c0;
                float sum[8];
#pragma unroll
                for (int e = 0; e < 8; ++e) sum[e] = 0.f;
                for (int i = 1; i < w; ++i) if (s0 - i >= 0) { const u32x4 q = *(const u32x4*)(up + (size_t)(r0 - i) * NQKU);
                    sum[0] += bf_lo(q.x); sum[1] += bf_hi(q.x); sum[2] += bf_lo(q.y); sum[3] += bf_hi(q.y); sum[4] += bf_lo(q.z); sum[5] += bf_hi(q.z); sum[6] += bf_lo(q.w); sum[7] += bf_hi(q.w); }
                for (int i = 0; i < 32; ++i) {
                    const int s = s0 + i; const u32x4 q = *(const u32x4*)(up + (size_t)(r0 + i) * NQKU);
                    const float cu[8] = {bf_lo(q.x), bf_hi(q.x), bf_lo(q.y), bf_hi(q.y), bf_lo(q.z), bf_hi(q.z), bf_lo(q.w), bf_hi(q.w)};
                    const float ic = 1.0f / (float)((s + 1) < w ? (s + 1) : w);
                    float o[8];
#pragma unroll
                    for (int e = 0; e < 8; ++e) { sum[e] += cu[e]; o[e] = sum[e] * ic - cu[e]; }
                    u32x4 ow; ow.x = cvt_pk_bf16(o[0], o[1]); ow.y = cvt_pk_bf16(o[2], o[3]); ow.z = cvt_pk_bf16(o[4], o[5]); ow.w = cvt_pk_bf16(o[6], o[7]);
                    *(u32x4*)(PL + (size_t)(r0 + i) * PWD + c0) = ow;
                    if (s - w + 1 >= 0) { const u32x4 p = *(const u32x4*)(up + (size_t)(r0 + i - w + 1) * NQKU);
                        sum[0] -= bf_lo(p.x); sum[1] -= bf_hi(p.x); sum[2] -= bf_lo(p.y); sum[3] -= bf_hi(p.y); sum[4] -= bf_lo(p.z); sum[5] -= bf_hi(p.z); sum[6] -= bf_lo(p.w); sum[7] -= bf_hi(p.w); }
                }
            }
        }
        END_PH();
        if (IN_PH()) {
            pg8::Gemm g{PL, Wpl, 256, PWD, 256, 256}; pg8::StaticOrder S; S.init(T, PWD, G, bx); pg8::EpiStore E{CC, DM, AW, a.pool_scale + (size_t)l * PWD};
            pg8::gemm_phase<pg8::EpiStore, pg8::StaticOrder, true>(lds, g, S, E);
        }
        END_PH();
        if (IN_PH()) {
            pg8::Gemm g{CC, Wo, DM, DM, DM, 0}; pg8::StaticOrder S; S.init(T, DM, G, bx); pg8::EpiStore E{MY, DM, 0, nullptr};
            pg8::gemm_phase<pg8::EpiStore, pg8::StaticOrder, true>(lds, g, S, E);
        }
        END_PH();
        if (IN_PH()) {
            OPAQUE_TID();
            const float* xin = (l == 0) ? a.x : a.out;
            for (int m = gw; m < T; m += NGW) res_norm_row(MY + (size_t)m * DM, xin + (size_t)m * DM, a.out + (size_t)m * DM, a.post_mix_g + (size_t)l * DM, a.pre_ffn_g + (size_t)l * DM, Hb + (size_t)m * DM, lane);
        }
        END_PH();
        if (IN_PH()) {
            pg8::Gemm g{Hb, Wup, DM, DM, DM, 0}; pg8::StaticOrder S; S.init(T, FF2, G, bx);
            pg8::EpiUpConv E{Gb, a.conv_w + (size_t)l * 3 * FF2, a.conv_b + (size_t)l * FF2, HALO, lds + XCH_OFF};
            pg8::gemm_phase<pg8::EpiUpConv, pg8::StaticOrder, true>(lds, g, S, E);
        }
        END_PH();
        if (IN_PH()) {
            OPAQUE_TID();
            const float* cw = a.conv_w + (size_t)l * 3 * FF2; const float* cb = a.conv_b + (size_t)l * FF2;
            for (int item = bx * 512 + tid; item < 128 * 2 * FF; item += G * 512) {
                const int c = item % FF, rr = (item / FF) & 1, pm = item / (2 * FF);
                float o2[2];
#pragma unroll
                for (int hf = 0; hf < 2; ++hf) { const int oc = hf * FF + c;
                    const float* hc = HALO + (size_t)pm * 4 * FF2 + oc; const float* hp = HALO + (size_t)(pm - 1) * 4 * FF2 + oc;
                    const bool first = (pm % 64) == 0;
                    const float r254 = first ? 0.f : hp[2 * FF2], r255 = first ? 0.f : hp[3 * FF2], r0v = hc[0], r1v = hc[FF2];
                    const float p2 = rr == 0 ? r254 : r255, p1 = rr == 0 ? r255 : r0v, cu = rr == 0 ? r0v : r1v;
                    o2[hf] = cb[oc] + cw[oc] * p2 + cw[FF2 + oc] * p1 + cw[2 * FF2 + oc] * cu; }
                const float o = pg8::gelu_tanh(o2[0]) * o2[1];
                Gb[(size_t)(pm * 256 + rr) * FF + c] = (bf16_t)f2bf(o);
            }
        }
        END_PH();
        if (IN_PH()) {
            pg8::Gemm g{Gb, Wdn, FF, FF, FF, 0}; pg8::StaticOrder S; S.init(T, DM, G, bx); pg8::EpiStore E{MY, DM, 0, nullptr};
            pg8::gemm_phase<pg8::EpiStore, pg8::StaticOrder, true>(lds, g, S, E);
        }
        END_PH();
        if (IN_PH()) {
            OPAQUE_TID();
            const bool lastl = (l == DEPTH - 1);
            for (int m = gw; m < T; m += NGW) res_norm_row(MY + (size_t)m * DM, a.out + (size_t)m * DM, a.out + (size_t)m * DM, a.post_ffn_g + (size_t)l * DM,
                                                            lastl ? nullptr : a.pre_mix_g + (size_t)(l + 1) * DM, lastl ? nullptr : Hb + (size_t)m * DM, lane);
        }
        END_PH();
    }
#undef IN_PH
#undef END_PH
}

extern "C" void kernel_launch(void* const* d_in, const int* in_sizes, int n_in, void* d_out, int out_size, void* d_ws, size_t ws_size, hipStream_t stream) {
    static int grid = 0;
    if (grid == 0) {
        if (n_in != 14 || out_size != T * DM || ws_size < WS_END) { fprintf(stderr, "kernel_launch: unexpected problem (n_in %d out %d ws %zu)\n", n_in, out_size, ws_size); grid = -1; return; }
        int dev = 0, cus = 0, per_cu = 0;
        hipGetDevice(&dev); hipDeviceGetAttribute(&cus, hipDeviceAttributeMultiprocessorCount, dev);
        hipFuncSetAttribute((const void*)fwd_megakernel, hipFuncAttributeMaxDynamicSharedMemorySize, LDS_BYTES);
        hipOccupancyMaxActiveBlocksPerMultiprocessor(&per_cu, (const void*)fwd_megakernel, 512, LDS_BYTES);
        (void)hipGetLastError();
        if (per_cu < 1) { fprintf(stderr, "kernel_launch: occupancy query says %d blocks per CU\n", per_cu); per_cu = 1; }
        grid = cus;
    }
    if (grid < 0) return;
    Args a{};
    a.x = (const float*)d_in[0]; a.pre_mix_g = (const float*)d_in[1]; a.w_in = (const float*)d_in[2]; a.rel_bias = (const float*)d_in[3]; a.pool_w = (const float*)d_in[4];
    a.pool_scale = (const float*)d_in[5]; a.w_o = (const float*)d_in[6]; a.post_mix_g = (const float*)d_in[7]; a.pre_ffn_g = (const float*)d_in[8]; a.w_up = (const float*)d_in[9];
    a.conv_w = (const float*)d_in[10]; a.conv_b = (const float*)d_in[11]; a.w_down = (const float*)d_in[12]; a.post_ffn_g = (const float*)d_in[13];
    a.out = (float*)d_out; a.ws = (unsigned char*)d_ws; a.pad = 0;
#if MK_COOP
    a.ph_lo = 0; a.ph_hi = N_PHASES; a.coop = 1;
    void* args[] = {&a};
    hipError_t e = hipLaunchCooperativeKernel((const void*)fwd_megakernel, dim3(grid), dim3(512), args, LDS_BYTES, stream);
    if (e != hipSuccess) fprintf(stderr, "cooperative launch failed: %s (grid %d)\n", hipGetErrorString(e), grid);
#else
    for (int p = 0; p < N_PHASES; ++p) { a.ph_lo = p; a.ph_hi = p + 1; a.coop = 0; hipLaunchKernelGGL(fwd_megakernel, dim3(grid), dim3(512), LDS_BYTES, stream, a); }
#endif
}
```

```cpp
#include <hip/hip_runtime.h>
#include <hip/hip_cooperative_groups.h>
#include <cstdio>
#include <cstdint>
namespace cg = cooperative_groups;

#ifndef MK_COOP
#define MK_COOP 1
#endif

#define LAS __attribute__((address_space(3)))
typedef unsigned short bf16_t;
typedef short bf16x8 __attribute__((ext_vector_type(8)));
typedef float f32x4 __attribute__((ext_vector_type(4)));
typedef float f32x2 __attribute__((ext_vector_type(2)));
typedef unsigned u32x4 __attribute__((ext_vector_type(4)));
typedef unsigned u32x2 __attribute__((ext_vector_type(2)));

constexpr int BATCH = 2, SEQ = 16384, T = BATCH * SEQ, DM = 2048, DEPTH = 2;
constexpr int NH = 8, HD = 128, AW = 1024, PWD = 1024, FF = 5632, FF2 = 11264, INW = 4096, NQKU = 3072;
constexpr int NREL = 257;
constexpr float NORM_EPS = 1e-6f;
constexpr float LOG2E = 1.4426950408889634f;

__device__ __forceinline__ unsigned cvt_pk_bf16(float lo, float hi) { unsigned r; asm volatile("v_cvt_pk_bf16_f32 %0, %1, %2" : "=v"(r) : "v"(lo), "v"(hi)); return r; }
__device__ __forceinline__ float bf_lo(unsigned w) { return __uint_as_float(w << 16); }
__device__ __forceinline__ float bf_hi(unsigned w) { return __uint_as_float(w & 0xffff0000u); }

namespace pg8 {
constexpr int BM = 256, BK = 64, HALF = 128, HTB = HALF * BK * 2, STAGE_BYTES = 8 * HTB, NXCD = 8, WGM = 8;

__host__ __device__ __forceinline__ int lds_byte(int r, int c) { const int st = (r >> 4) * 2 + (c >> 5), rr = r & 15, cc = c & 31, ob = rr * 64 + cc * 2; return st * 1024 + (ob ^ (((ob >> 9) & 1) << 5)); }
__host__ __device__ __forceinline__ void stage_rc(int b, int& R, int& C) { const int st = b / 1024, sb = b % 1024, swz = sb ^ (((sb >> 9) & 1) << 5); R = (st >> 1) * 16 + swz / 64; C = (st & 1) * 32 + (swz % 64) / 2; }
__host__ __device__ __forceinline__ int perm32(int rho) { const int n = rho >> 4, i = rho & 15; return 8 * (i >> 2) + 4 * n + (i & 3); }

struct Unit { int pm, pn; };
struct Gemm { const bf16_t* A; const bf16_t* Bt; int K, lda, ldb, a_col_per_pn; };

struct StaticOrder {
    int nM, nN, nwg, G, c;
    __host__ __device__ void init(int M, int N, int G_, int c_) { nM = M / BM; nN = N / BM; nwg = nM * nN; G = G_; c = c_; }
    __host__ __device__ bool next(int i, Unit& u) const {
        const long L = (long)i * G + c; if (L >= nwg) return false;
        int wgid = (int)L; { const int q = nwg / NXCD, r = nwg % NXCD, xcd = wgid % NXCD, off = wgid / NXCD; wgid = (xcd < r ? xcd * (q + 1) : r * (q + 1) + (xcd - r) * q) + off; }
        const int nig = WGM * nN, gid = wgid / nig, fm = gid * WGM, gsz = (nM - fm) < WGM ? (nM - fm) : WGM;
        u.pm = fm + ((wgid % nig) % gsz); u.pn = (wgid % nig) / gsz; return true;
    }
};

struct EpiStore {
    static constexpr bool PERM = true;
    bf16_t* O; int ldc; int col_off; const float* colscale;
    __device__ __forceinline__ void operator()(const f32x4 (&acc)[2][2][4][2], const Unit& u, int wr, int wc, int fr, int fq) const {
        const int row0 = u.pm * BM + wr * 64 + fr; const int col0 = u.pn * BM + wc * 32 + 8 * fq;
        f32x4 sv[2][2];
#pragma unroll
        for (int bj = 0; bj < 2; ++bj)
#pragma unroll
            for (int n = 0; n < 2; ++n) sv[bj][n] = colscale ? *(const f32x4*)(colscale + col0 + bj * HALF + 4 * n) : (f32x4){1.f, 1.f, 1.f, 1.f};
#pragma unroll
        for (int ai = 0; ai < 2; ++ai)
#pragma unroll
            for (int m = 0; m < 4; ++m) { bf16_t* rowp = O + (size_t)(row0 + ai * HALF + m * 16) * ldc + col_off + col0;
#pragma unroll
                for (int bj = 0; bj < 2; ++bj) { f32x4 v0 = acc[ai][bj][m][0] * sv[bj][0], v1 = acc[ai][bj][m][1] * sv[bj][1];
                    u32x4 w; w.x = cvt_pk_bf16(v0[0], v0[1]); w.y = cvt_pk_bf16(v0[2], v0[3]); w.z = cvt_pk_bf16(v1[0], v1[1]); w.w = cvt_pk_bf16(v1[2], v1[3]);
                    *(u32x4*)(rowp + bj * HALF) = w; } }
    }
};

#define DPPF(old, src, ctrl) __builtin_bit_cast(float, __builtin_amdgcn_update_dpp(__builtin_bit_cast(int, (float)(old)), __builtin_bit_cast(int, (float)(src)), (ctrl), 0xf, 0xf, false))
__device__ __forceinline__ float gelu_tanh(float x) {
    const float u = x * (1.0f + 0.044715f * x * x);
    const float e = __builtin_amdgcn_exp2f(-2.3022081985f * u);
    return x * __builtin_amdgcn_rcpf(1.0f + e);
}
struct EpiUpConv {
    static constexpr bool PERM = true;
    bf16_t* G; const float* cw; const float* cb; float* halo; LAS unsigned char* xl;
    __device__ __forceinline__ void operator()(const f32x4 (&acc)[2][2][4][2], const Unit& u, int wr, int wc, int fr, int fq) const {
        LAS f32x4* X = (LAS f32x4*)xl;
        const int colg = u.pn * 128 + wc * 32 + 8 * fq;
        if (fr >= 14) {
#pragma unroll
            for (int ai = 0; ai < 2; ++ai)
#pragma unroll
                for (int bj = 0; bj < 2; ++bj)
#pragma unroll
                    for (int n = 0; n < 2; ++n) X[(((((ai * 2 + wr) * 4 + wc) * 2 + bj) * 2 + n) * 2 + (fr - 14)) * 4 + fq] = acc[ai][bj][3][n];
            if (wr == 1) {
#pragma unroll
                for (int bj = 0; bj < 2; ++bj)
#pragma unroll
                    for (int n = 0; n < 2; ++n) *(f32x4*)(halo + ((size_t)u.pm * 4 + 2 + (fr - 14)) * FF2 + bj * FF + colg + 4 * n) = acc[1][bj][3][n];
            }
        }
        if (wr == 0 && fr < 2) {
#pragma unroll
            for (int bj = 0; bj < 2; ++bj)
#pragma unroll
                for (int n = 0; n < 2; ++n) *(f32x4*)(halo + ((size_t)u.pm * 4 + fr) * FF2 + bj * FF + colg + 4 * n) = acc[0][bj][0][n];
        }
        asm volatile("s_waitcnt lgkmcnt(0)" ::: "memory"); __builtin_amdgcn_s_barrier(); asm volatile("" ::: "memory");
#pragma unroll
        for (int n = 0; n < 2; ++n) {
            f32x4 w0[2], w1[2], w2[2], bb[2];
#pragma unroll
            for (int bj = 0; bj < 2; ++bj) { const int oc = bj * FF + colg + 4 * n;
                w0[bj] = *(const f32x4*)(cw + oc); w1[bj] = *(const f32x4*)(cw + FF2 + oc); w2[bj] = *(const f32x4*)(cw + 2 * FF2 + oc); bb[bj] = *(const f32x4*)(cb + oc); }
#pragma unroll
            for (int ai = 0; ai < 2; ++ai) {
                const int seg = ai * 2 + wr;
                f32x4 vp[2];
#pragma unroll
                for (int bj = 0; bj < 2; ++bj) { vp[bj] = (f32x4){0.f, 0.f, 0.f, 0.f};
                    if (seg > 0 && fr >= 14) vp[bj] = X[((((((seg - 1) * 4 + wc) * 2 + bj) * 2 + n) * 2 + (fr - 14)) * 4) + fq]; }
#pragma unroll
                for (int m = 0; m < 4; ++m) {
                    f32x4 cv[2];
#pragma unroll
                    for (int bj = 0; bj < 2; ++bj) { const f32x4 cur = acc[ai][bj][m][n]; const f32x4 prv = (m == 0) ? vp[bj] : acc[ai][bj][m == 0 ? 0 : m - 1][n];
#pragma unroll
                        for (int j = 0; j < 4; ++j) { const float t1 = DPPF(0.f, prv[j], 0x121), p1 = DPPF(t1, cur[j], 0x111); const float t2 = DPPF(0.f, prv[j], 0x122), p2 = DPPF(t2, cur[j], 0x112);
                            cv[bj][j] = bb[bj][j] + w0[bj][j] * p2 + w1[bj][j] * p1 + w2[bj][j] * cur[j]; } }
                    f32x4 o;
#pragma unroll
                    for (int j = 0; j < 4; ++j) o[j] = gelu_tanh(cv[0][j]) * cv[1][j];
                    u32x2 w; w.x = cvt_pk_bf16(o[0], o[1]); w.y = cvt_pk_bf16(o[2], o[3]);
                    *(u32x2*)(G + (size_t)(u.pm * BM + ai * HALF + wr * 64 + m * 16 + fr) * FF + colg + 4 * n) = w;
                }
            }
        }
    }
};

template <class Epi, class Sched, bool ALIGN_EPI = false>
__device__ __forceinline__ void gemm_phase(LAS unsigned char* lds, const Gemm g, const Sched& S, const Epi& E) {
    int tid_ = threadIdx.x; asm volatile("" : "+v"(tid_));
    const int tid = tid_, wid = __builtin_amdgcn_readfirstlane(tid >> 6), lane = tid & 63, wr = wid >> 2, wc = wid & 3, fr = lane & 15, fq = lane >> 4;
    const int K = g.K, nt = K / BK;
    unsigned voffA[2], voffB[2];
#pragma unroll
    for (int i = 0; i < 2; ++i) { int R, C; stage_rc(tid * 16 + i * 8192, R, C); const int Rb = Epi::PERM ? ((R & ~31) + perm32(R & 31)) : R;
        voffA[i] = (unsigned)(R * g.lda + C) * 2u; voffB[i] = (unsigned)(Rb * g.ldb + C) * 2u; }
    const size_t kstep = (size_t)(BK * 2);
    const size_t hstepA = (size_t)HALF * g.lda * 2, hstepB = (size_t)HALF * g.ldb * 2;
    const unsigned ldsw = (unsigned)wid * 1024u;
    const int aoff = lds_byte(wr * 64 + fr, fq * 8), boff = lds_byte(wc * 32 + fr, fq * 8);
#define PG8_SA(b, h) (((b) * 2 + (h)) * HTB)
#define PG8_SB(b, h) ((4 + (b) * 2 + (h)) * HTB)
#define PG8_STAGE(bufoff, gbase, voff) do { _Pragma("unroll") for (int _i = 0; _i < 2; ++_i) \
        __builtin_amdgcn_global_load_lds((const unsigned*)((const char*)(gbase) + (voff)[_i]), (LAS unsigned*)(lds + (bufoff) + ldsw + _i * 8192), 16, 0, 0); } while (0)
#define PG8_LDA(dst, b, h) do { _Pragma("unroll") for (int m = 0; m < 4; ++m) _Pragma("unroll") for (int k = 0; k < 2; ++k) dst[m][k] = *(const LAS bf16x8*)(lds + PG8_SA(b, h) + aoff + m * 2048 + k * 1024); } while (0)
#define PG8_LDB(dst, b, h) do { _Pragma("unroll") for (int n = 0; n < 2; ++n) _Pragma("unroll") for (int k = 0; k < 2; ++k) dst[n][k] = *(const LAS bf16x8*)(lds + PG8_SB(b, h) + boff + n * 2048 + k * 1024); } while (0)
#define PG8_MMA(ai, bj, At, Bt) do { __builtin_amdgcn_s_setprio(1); _Pragma("unroll") for (int m = 0; m < 4; ++m) _Pragma("unroll") for (int n = 0; n < 2; ++n) _Pragma("unroll") for (int k = 0; k < 2; ++k) \
        acc[ai][bj][m][n] = __builtin_amdgcn_mfma_f32_16x16x32_bf16(Bt[n][k], At[m][k], acc[ai][bj][m][n], 0, 0, 0); __builtin_amdgcn_s_setprio(0); } while (0)
#define PG8_WAIT_V(n) asm volatile("s_waitcnt vmcnt(" #n ")" ::: "memory")
#define PG8_WAIT_L(n) asm volatile("s_waitcnt lgkmcnt(" #n ")" ::: "memory")
#define PG8_BAR __builtin_amdgcn_s_barrier()
#define PG8_SCHED __builtin_amdgcn_sched_barrier(0)
#define PG8_UA(u) ((const char*)g.A + (size_t)(u).pm * 2 * hstepA + (size_t)(u).pn * (size_t)g.a_col_per_pn * 2)
#define PG8_UB(u) ((const char*)g.Bt + (size_t)(u).pn * 2 * hstepB)
    Unit cur, nxt; int ui = 0;
    if (!S.next(0, cur)) return;
    f32x4 acc[2][2][4][2];
#pragma unroll
    for (int a = 0; a < 2; ++a)
#pragma unroll
        for (int b = 0; b < 2; ++b)
#pragma unroll
            for (int m = 0; m < 4; ++m)
#pragma unroll
                for (int n = 0; n < 2; ++n) acc[a][b][m][n] = (f32x4){0.f, 0.f, 0.f, 0.f};
    bf16x8 At[4][2], B0[2][2], B1[2][2];
    const char* cA = PG8_UA(cur); const char* cB = PG8_UB(cur);
    PG8_STAGE(PG8_SB(0, 0), cB, voffB); PG8_STAGE(PG8_SB(0, 1), cB + hstepB, voffB); PG8_STAGE(PG8_SA(0, 0), cA, voffA); PG8_STAGE(PG8_SA(0, 1), cA + hstepA, voffA);
    if (wr == 1) PG8_BAR;
    PG8_WAIT_V(2); PG8_BAR;
    PG8_STAGE(PG8_SB(1, 0), cB + kstep, voffB); PG8_STAGE(PG8_SA(1, 0), cA + kstep, voffA); PG8_STAGE(PG8_SB(1, 1), cB + hstepB + kstep, voffB);
    PG8_WAIT_V(6); PG8_BAR;
    for (;;) {
        const bool has_next = S.next(ui + 1, nxt);
        const char* nA = has_next ? PG8_UA(nxt) : cA; const char* nB = has_next ? PG8_UB(nxt) : cB;
        for (int t = 0; t < nt; t += 2) {
            const bool last = (t == nt - 2);
            const char* a1 = cA + (size_t)(t + 1) * kstep;
            const char* a2 = last ? nA : cA + (size_t)(t + 2) * kstep; const char* b2 = last ? nB : cB + (size_t)(t + 2) * kstep;
            const char* a3 = a2 + kstep; const char* b3 = b2 + kstep;
            PG8_LDB(B0, 0, 0); PG8_LDB(B1, 0, 1); PG8_SCHED; PG8_LDA(At, 0, 0); PG8_STAGE(PG8_SA(1, 1), a1 + hstepA, voffA);
            PG8_WAIT_V(8); PG8_WAIT_L(0); PG8_BAR; PG8_MMA(0, 0, At, B0); PG8_MMA(0, 1, At, B1); PG8_BAR; PG8_SCHED;
            PG8_LDA(At, 0, 1); PG8_STAGE(PG8_SB(0, 0), b2, voffB); PG8_STAGE(PG8_SB(0, 1), b2 + hstepB, voffB); PG8_STAGE(PG8_SA(0, 0), a2, voffA);
            PG8_WAIT_V(8); PG8_WAIT_L(0); PG8_BAR; PG8_MMA(1, 0, At, B0); PG8_MMA(1, 1, At, B1); PG8_BAR; PG8_SCHED;
            PG8_LDB(B0, 1, 0); PG8_LDB(B1, 1, 1); PG8_SCHED; PG8_LDA(At, 1, 0); PG8_STAGE(PG8_SA(0, 1), a2 + hstepA, voffA);
            PG8_WAIT_V(8); PG8_WAIT_L(0); PG8_BAR; PG8_MMA(0, 0, At, B0); PG8_MMA(0, 1, At, B1); PG8_BAR; PG8_SCHED;
            PG8_LDA(At, 1, 1); PG8_STAGE(PG8_SB(1, 0), b3, voffB); PG8_STAGE(PG8_SB(1, 1), b3 + hstepB, voffB); PG8_STAGE(PG8_SA(1, 0), a3, voffA);
            PG8_WAIT_V(8); PG8_WAIT_L(0); PG8_BAR; PG8_MMA(1, 0, At, B0); PG8_MMA(1, 1, At, B1); PG8_BAR; PG8_SCHED;
        }
        if constexpr (ALIGN_EPI) { if (wr == 0) PG8_BAR; }
        E(acc, cur, wr, wc, fr, fq);
        if (!has_next) break;
#pragma unroll
        for (int a = 0; a < 2; ++a)
#pragma unroll
            for (int b = 0; b < 2; ++b)
#pragma unroll
                for (int m = 0; m < 4; ++m)
#pragma unroll
                    for (int n = 0; n < 2; ++n) acc[a][b][m][n] = (f32x4){0.f, 0.f, 0.f, 0.f};
        cur = nxt; cA = nA; cB = nB; ++ui;
        if constexpr (ALIGN_EPI) { if (wr == 1) PG8_BAR; }
    }
    PG8_WAIT_V(0);
    if constexpr (!ALIGN_EPI) { if (wr == 0) PG8_BAR; }
    PG8_BAR;
#undef PG8_SA
#undef PG8_SB
#undef PG8_STAGE
#undef PG8_LDA
#undef PG8_LDB
#undef PG8_MMA
#undef PG8_WAIT_V
#undef PG8_WAIT_L
#undef PG8_BAR
#undef PG8_SCHED
#undef PG8_UA
#undef PG8_UB
}
}

constexpr size_t MiB = 1u << 20;
constexpr size_t WS_W = 1 * MiB, W_LAYER = 91 * MiB;
constexpr size_t WO_IN = 0, WO_O = 16 * MiB, WO_UP = 24 * MiB, WO_DOWN = 68 * MiB, WO_POOL = 90 * MiB;
constexpr size_t WS_H = 183 * MiB;
constexpr size_t WS_QKU = 311 * MiB, WS_VT = 503 * MiB, WS_CC = 567 * MiB;
constexpr size_t WS_G = 311 * MiB;
constexpr size_t WS_POOLED = 695 * MiB;
constexpr size_t WS_MY = 759 * MiB;
constexpr size_t WS_HALO = 887 * MiB;
constexpr size_t WS_END = 909 * MiB;

constexpr int RING_BYTES = 131072, XCH_OFF = RING_BYTES, LDS_BYTES = 147456;

struct Args {
    const float* x; const float* pre_mix_g; const float* w_in; const float* rel_bias; const float* pool_w; const float* pool_scale; const float* w_o;
    const float* post_mix_g; const float* pre_ffn_g; const float* w_up; const float* conv_w; const float* conv_b; const float* w_down; const float* post_ffn_g;
    float* out; unsigned char* ws; int ph_lo, ph_hi, coop, pad;
};

__device__ __forceinline__ float wave_sum(float v) {
#pragma unroll
    for (int o = 1; o < 64; o <<= 1) v += __shfl_xor(v, o);
    return v;
}
__device__ __forceinline__ unsigned f2bf(float f) { unsigned u = __builtin_bit_cast(unsigned, f); return (u + 0x7fffu + ((u >> 16) & 1u)) >> 16; }
__device__ __forceinline__ unsigned pk2(float lo, float hi) { return f2bf(lo) | (f2bf(hi) << 16); }

__device__ __forceinline__ void transpose_item(const float* W, int N, bf16_t* WT, int ldk, int k0, int n0, int drow0, LAS float* scr, int lane) {
#pragma unroll 8
    for (int i = 0; i < 32; ++i) { const int kk = 2 * i + (lane >> 5); scr[kk * 33 + (lane & 31)] = W[(size_t)(k0 + kk) * N + n0 + (lane & 31)]; }
    asm volatile("s_waitcnt lgkmcnt(0)" ::: "memory");
    const int c = lane & 7;
#pragma unroll
    for (int j = 0; j < 4; ++j) { const int n = (lane >> 3) + 8 * j; const LAS float* s = scr + (8 * c) * 33 + n;
        u32x4 o; o.x = pk2(s[0 * 33], s[1 * 33]); o.y = pk2(s[2 * 33], s[3 * 33]); o.z = pk2(s[4 * 33], s[5 * 33]); o.w = pk2(s[6 * 33], s[7 * 33]);
        *(u32x4*)(WT + (size_t)(drow0 + n) * ldk + k0 + 8 * c) = o; }
    asm volatile("s_waitcnt lgkmcnt(0)" ::: "memory");
}

__device__ __forceinline__ void rms_row_to_bf16(const float* xrow, const float* g, bf16_t* orow, int lane) {
    f32x4 v[8]; float s = 0.f;
#pragma unroll
    for (int j = 0; j < 4; ++j) { v[2 * j] = *(const f32x4*)(xrow + 8 * (lane + 64 * j)); v[2 * j + 1] = *(const f32x4*)(xrow + 8 * (lane + 64 * j) + 4); }
#pragma unroll
    for (int j = 0; j < 8; ++j) s += (v[j].x * v[j].x + v[j].y * v[j].y) + (v[j].z * v[j].z + v[j].w * v[j].w);
    const float rstd = 1.0f / sqrtf(wave_sum(s) * (1.0f / DM) + NORM_EPS);
#pragma unroll
    for (int j = 0; j < 4; ++j) { const int c = 8 * (lane + 64 * j); const f32x4 g0 = *(const f32x4*)(g + c), g1 = *(const f32x4*)(g + c + 4); const f32x4 a = v[2 * j] * rstd * g0, b = v[2 * j + 1] * rstd * g1;
        u32x4 w; w.x = cvt_pk_bf16(a.x, a.y); w.y = cvt_pk_bf16(a.z, a.w); w.z = cvt_pk_bf16(b.x, b.y); w.w = cvt_pk_bf16(b.z, b.w); *(u32x4*)(orow + c) = w; }
}

__device__ __forceinline__ void res_norm_row(const bf16_t* mrow, const float* xin, float* xout, const float* g1, const float* g2, bf16_t* hrow, int lane) {
    f32x4 v[8]; float s = 0.f;
#pragma unroll
    for (int j = 0; j < 4; ++j) { const u32x4 w = *(const u32x4*)(mrow + 8 * (lane + 64 * j));
        v[2 * j] = (f32x4){bf_lo(w.x), bf_hi(w.x), bf_lo(w.y), bf_hi(w.y)}; v[2 * j + 1] = (f32x4){bf_lo(w.z), bf_hi(w.z), bf_lo(w.w), bf_hi(w.w)}; }
#pragma unroll
    for (int j = 0; j < 8; ++j) s += (v[j].x * v[j].x + v[j].y * v[j].y) + (v[j].z * v[j].z + v[j].w * v[j].w);
    const float rstd = 1.0f / sqrtf(wave_sum(s) * (1.0f / DM) + NORM_EPS);
    float s2 = 0.f;
#pragma unroll
    for (int j = 0; j < 8; ++j) { const int c = 8 * (lane + 64 * (j >> 1)) + 4 * (j & 1); const f32x4 gg = *(const f32x4*)(g1 + c); const f32x4 xi = *(const f32x4*)(xin + c);
        v[j] = xi + v[j] * rstd * gg; *(f32x4*)(xout + c) = v[j]; s2 += (v[j].x * v[j].x + v[j].y * v[j].y) + (v[j].z * v[j].z + v[j].w * v[j].w); }
    if (hrow) {
        const float rstd2 = 1.0f / sqrtf(wave_sum(s2) * (1.0f / DM) + NORM_EPS);
#pragma unroll
        for (int j = 0; j < 4; ++j) { const int c = 8 * (lane + 64 * j); const f32x4 g0 = *(const f32x4*)(g2 + c), g1v = *(const f32x4*)(g2 + c + 4); const f32x4 a = v[2 * j] * rstd2 * g0, b = v[2 * j + 1] * rstd2 * g1v;
            u32x4 w; w.x = cvt_pk_bf16(a.x, a.y); w.y = cvt_pk_bf16(a.z, a.w); w.z = cvt_pk_bf16(b.x, b.y); w.w = cvt_pk_bf16(b.z, b.w); *(u32x4*)(hrow + c) = w; }
    }
}

constexpr int AT_BT = 0, AT_BUF = 8448, AT_KSTR = 272, AT_VSTR = 144, AT_VOFF = 64 * AT_KSTR, AT_BUFSZ = AT_VOFF + 128 * AT_VSTR;
static_assert(AT_BUF + 2 * AT_BUFSZ <= RING_BYTES, "attention LDS");
__device__ __forceinline__ void attn_phase(LAS unsigned char* lds, const bf16_t* QKU, const bf16_t* VT, bf16_t* CC, const float* relb, int vcu, int G) {
    int tid_ = threadIdx.x; asm volatile("" : "+v"(tid_));
    const int tid = tid_, wid = __builtin_amdgcn_readfirstlane(tid >> 6), lane = tid & 63, fr = lane & 15, fq = lane >> 4;
    LAS float* bt = (LAS float*)(lds + AT_BT);
    for (int i = tid; i < NH * NREL; i += 512) bt[(i / NREL) * 260 + (i % NREL)] = relb[i] * LOG2E;
    __syncthreads();
    const float SC = 0.08838834764831845f * LOG2E;
    for (int unit = vcu; unit < BATCH * NH * 128; unit += G) {
        const int bh = unit >> 7, np = unit & 127, b = bh >> 3, h = bh & 7;
        const int qc = 2 * np + (wid >> 2), ql = (wid & 3) * 16 + fr;
        const size_t trow = (size_t)b * SEQ + qc * 64 + ql;
        bf16x8 Qf[4];
#pragma unroll
        for (int ds = 0; ds < 4; ++ds) Qf[ds] = *(const bf16x8*)(QKU + trow * NQKU + h * HD + 32 * ds + 8 * fq);
        const int kc_lo = (2 * np - 8) > 0 ? (2 * np - 8) : 0, kc_hi = 2 * np + 1;
        const int my_lo = (qc - 8) > 0 ? (qc - 8) : 0, my_hi = qc;
        f32x4 O[8];
#pragma unroll
        for (int d = 0; d < 8; ++d) O[d] = (f32x4){0.f, 0.f, 0.f, 0.f};
        float mrun = -1e30f, lrun = 0.f;
        const LAS float* bth = bt + h * 260;
        const int kr0 = tid >> 4, kc16 = tid & 15, vr0 = tid >> 3, vc16 = tid & 7;
        const bf16_t* ksrc = QKU + ((size_t)b * SEQ + kr0) * NQKU + AW + h * HD + kc16 * 8;
        const bf16_t* vsrc = VT + (size_t)(h * HD + vr0) * T + (size_t)b * SEQ + vc16 * 8;
        const int kdst = kr0 * AT_KSTR + kc16 * 16, vdst = AT_VOFF + vr0 * AT_VSTR + vc16 * 16;
        u32x4 kreg[2], vreg[2];
#define AT_LOAD(kc) do { kreg[0] = *(const u32x4*)(ksrc + (size_t)(kc) * 64 * NQKU); kreg[1] = *(const u32x4*)(ksrc + ((size_t)(kc) * 64 + 32) * NQKU); \
                         vreg[0] = *(const u32x4*)(vsrc + (size_t)(kc) * 64); vreg[1] = *(const u32x4*)(vsrc + (size_t)64 * T + (size_t)(kc) * 64); } while (0)
#define AT_STORE(buf) do { LAS unsigned char* bb_ = lds + AT_BUF + (buf) * AT_BUFSZ; *(LAS u32x4*)(bb_ + kdst) = kreg[0]; *(LAS u32x4*)(bb_ + kdst + 32 * AT_KSTR) = kreg[1]; \
                           *(LAS u32x4*)(bb_ + vdst) = vreg[0]; *(LAS u32x4*)(bb_ + vdst + 64 * AT_VSTR) = vreg[1]; } while (0)
        AT_LOAD(kc_lo); AT_STORE(0);
        __syncthreads();
        for (int kc = kc_lo; kc <= kc_hi; ++kc) {
            const int cur = (kc - kc_lo) & 1;
            if (kc < kc_hi) AT_LOAD(kc + 1);
            if (kc >= my_lo && kc <= my_hi) {
                const LAS unsigned char* Kb = lds + AT_BUF + cur * AT_BUFSZ; const LAS unsigned char* Vb = Kb + AT_VOFF;
                f32x4 s[4];
#pragma unroll
                for (int kb = 0; kb < 4; ++kb) { s[kb] = (f32x4){0.f, 0.f, 0.f, 0.f};
                    const int krow = 32 * (kb >> 1) + 8 * (fr >> 2) + 4 * (kb & 1) + (fr & 3);
#pragma unroll
                    for (int ds = 0; ds < 4; ++ds) { const bf16x8 kf = *(const LAS bf16x8*)(Kb + krow * AT_KSTR + (32 * ds + 8 * fq) * 2);
                        s[kb] = __builtin_amdgcn_mfma_f32_16x16x32_bf16(kf, Qf[ds], s[kb], 0, 0, 0); } }
                const int dch = qc - kc;
                if (dch >= 3) { const float cbias = bth[256];
#pragma unroll
                    for (int kb = 0; kb < 4; ++kb) s[kb] = s[kb] * SC + cbias;
                } else {
                    const int rb = 64 * dch + ql - 8 * fq + 128;
#pragma unroll
                    for (int kb = 0; kb < 4; ++kb)
#pragma unroll
                        for (int j = 0; j < 4; ++j) { int idx = rb - (32 * (kb >> 1) + 4 * (kb & 1) + j); idx = idx > 256 ? 256 : idx; s[kb][j] = s[kb][j] * SC + bth[idx]; }
                }
                float mx = s[0][0];
#pragma unroll
                for (int kb = 0; kb < 4; ++kb)
#pragma unroll
                    for (int j = 0; j < 4; ++j) mx = fmaxf(mx, s[kb][j]);
                mx = fmaxf(mx, __shfl_xor(mx, 16)); mx = fmaxf(mx, __shfl_xor(mx, 32));
                const float mnew = fmaxf(mrun, mx), alpha = __builtin_amdgcn_exp2f(mrun - mnew); mrun = mnew;
                float ps = 0.f;
#pragma unroll
                for (int kb = 0; kb < 4; ++kb)
#pragma unroll
                    for (int j = 0; j < 4; ++j) { s[kb][j] = __builtin_amdgcn_exp2f(s[kb][j] - mnew); ps += s[kb][j]; }
                lrun = lrun * alpha + ps;
#pragma unroll
                for (int d = 0; d < 8; ++d) O[d] = O[d] * alpha;
                bf16x8 Pf[2];
#pragma unroll
                for (int ks = 0; ks < 2; ++ks) { u32x4 w; w.x = cvt_pk_bf16(s[2 * ks][0], s[2 * ks][1]); w.y = cvt_pk_bf16(s[2 * ks][2], s[2 * ks][3]);
                    w.z = cvt_pk_bf16(s[2 * ks + 1][0], s[2 * ks + 1][1]); w.w = cvt_pk_bf16(s[2 * ks + 1][2], s[2 * ks + 1][3]); Pf[ks] = __builtin_bit_cast(bf16x8, w); }
#pragma unroll
                for (int d = 0; d < 8; ++d)
#pragma unroll
                    for (int ks = 0; ks < 2; ++ks) { const bf16x8 vf = *(const LAS bf16x8*)(Vb + (16 * d + fr) * AT_VSTR + (32 * ks + 8 * fq) * 2);
                        O[d] = __builtin_amdgcn_mfma_f32_16x16x32_bf16(vf, Pf[ks], O[d], 0, 0, 0); }
            }
            if (kc < kc_hi) AT_STORE(cur ^ 1);
            __syncthreads();
        }
#undef AT_LOAD
#undef AT_STORE
        float lt = lrun; lt += __shfl_xor(lt, 16); lt += __shfl_xor(lt, 32);
        const float inv = 1.0f / lt;
        bf16_t* op = CC + trow * DM + h * HD + 4 * fq;
#pragma unroll
        for (int d = 0; d < 8; ++d) { const f32x4 o = O[d] * inv; u32x2 w; w.x = cvt_pk_bf16(o[0], o[1]); w.y = cvt_pk_bf16(o[2], o[3]); *(u32x2*)(op + 16 * d) = w; }
    }
}

constexpr int N_PHASES = 1 + 9 * DEPTH;
__global__ void __launch_bounds__(512, 2) fwd_megakernel(Args a) {
    extern __shared__ __attribute__((aligned(16))) unsigned char lds_raw[];
    LAS unsigned char* lds = (LAS unsigned char*)lds_raw;
    const int wave = __builtin_amdgcn_readfirstlane((int)threadIdx.x >> 6);
    const int G = gridDim.x, bx = blockIdx.x;
#define OPAQUE_TID() int tid = threadIdx.x; asm volatile("" : "+v"(tid)); const int lane = tid & 63; (void)lane
    const int vcu = (G % 8 == 0) ? (bx % 8) * (G / 8) + bx / 8 : bx;
    const int gw = vcu * 8 + wave, NGW = G * 8;
    unsigned char* ws = a.ws;
    bf16_t* Hb = (bf16_t*)(ws + WS_H); bf16_t* QKU = (bf16_t*)(ws + WS_QKU); bf16_t* VT = (bf16_t*)(ws + WS_VT); bf16_t* CC = (bf16_t*)(ws + WS_CC);
    bf16_t* Gb = (bf16_t*)(ws + WS_G); bf16_t* PL = (bf16_t*)(ws + WS_POOLED); bf16_t* MY = (bf16_t*)(ws + WS_MY); float* HALO = (float*)(ws + WS_HALO);
    const int lo = a.ph_lo, hi = a.ph_hi;
    int ph = 0;
#define IN_PH() (lo <= ph && ph < hi)
#define END_PH() do { ++ph; if (a.coop && lo < ph && ph < hi) cg::this_grid().sync(); } while (0)

    if (IN_PH()) {
        OPAQUE_TID();
        LAS float* scr = (LAS float*)(lds + wave * 16384);
        constexpr int I_IN = (DM / 64) * (INW / 32), I_O = (DM / 64) * (DM / 32), I_UP = (DM / 64) * (FF2 / 32), I_DN = (FF / 64) * (DM / 32), I_PL = 4 * (256 / 64) * (256 / 32);
        constexpr int I_LAYER = I_IN + I_O + I_UP + I_DN + I_PL;
        for (int it = gw; it < DEPTH * I_LAYER; it += NGW) {
            const int l = it / I_LAYER; int r = it % I_LAYER;
            unsigned char* wl = ws + WS_W + (size_t)l * W_LAYER;
            if (r < I_IN) { const int nblk = INW / 32, kb = r / nblk, nb = r % nblk, n0 = 32 * nb;
                const int drow = n0 < 2048 ? n0 : (n0 < 3072 ? n0 + 1024 : n0 - 1024);
                transpose_item(a.w_in + (size_t)l * DM * INW, INW, (bf16_t*)(wl + WO_IN), DM, 64 * kb, n0, drow, scr, lane); continue; } r -= I_IN;
            if (r < I_O) { const int nblk = DM / 32, kb = r / nblk, nb = r % nblk;
                transpose_item(a.w_o + (size_t)l * DM * DM, DM, (bf16_t*)(wl + WO_O), DM, 64 * kb, 32 * nb, 32 * nb, scr, lane); continue; } r -= I_O;
            if (r < I_UP) { const int nblk = FF2 / 32, kb = r / nblk, nb = r % nblk, n0 = 32 * nb;
                const int half = n0 >= FF ? 1 : 0, cc = n0 - half * FF; const int drow = 256 * (cc >> 7) + 128 * half + (cc & 127);
                transpose_item(a.w_up + (size_t)l * DM * FF2, FF2, (bf16_t*)(wl + WO_UP), DM, 64 * kb, n0, drow, scr, lane); continue; } r -= I_UP;
            if (r < I_DN) { const int nblk = DM / 32, kb = r / nblk, nb = r % nblk;
                transpose_item(a.w_down + (size_t)l * FF * DM, DM, (bf16_t*)(wl + WO_DOWN), FF, 64 * kb, 32 * nb, 32 * nb, scr, lane); continue; } r -= I_DN;
            { const int gidx = r / 32, rr = r % 32, kb = rr / 8, nb = rr % 8;
                transpose_item(a.pool_w + ((size_t)l * 4 + gidx) * 65536, 256, (bf16_t*)(wl + WO_POOL) + (size_t)gidx * 65536, 256, 64 * kb, 32 * nb, 32 * nb, scr, lane); }
        }
        for (int m = gw; m < T; m += NGW) rms_row_to_bf16(a.x + (size_t)m * DM, a.pre_mix_g, Hb + (size_t)m * DM, lane);
    }
    END_PH();

    for (int l = 0; l < DEPTH; ++l) {
        unsigned char* wl = ws + WS_W + (size_t)l * W_LAYER;
        const bf16_t* Win = (const bf16_t*)(wl + WO_IN); const bf16_t* Wo = (const bf16_t*)(wl + WO_O); const bf16_t* Wup = (const bf16_t*)(wl + WO_UP);
        const bf16_t* Wdn = (const bf16_t*)(wl + WO_DOWN); const bf16_t* Wpl = (const bf16_t*)(wl + WO_POOL);
        if (IN_PH()) {
            { pg8::Gemm g{Hb, Win, DM, DM, DM, 0}; pg8::StaticOrder S; S.init(T, NQKU, G, bx); pg8::EpiStore E{QKU, NQKU, 0, nullptr};
              pg8::gemm_phase<pg8::EpiStore, pg8::StaticOrder, true>(lds, g, S, E); }
            { pg8::Gemm g{Win + (size_t)NQKU * DM, Hb, DM, DM, DM, 0}; pg8::StaticOrder S; S.init(AW, T, G, bx); pg8::EpiStore E{VT, T, 0, nullptr};
              pg8::gemm_phase<pg8::EpiStore, pg8::StaticOrder, true>(lds, g, S, E); }
        }
        END_PH();
        if (IN_PH()) {
            attn_phase(lds, QKU, VT, CC, a.rel_bias + (size_t)l * NH * NREL, vcu, G);
            OPAQUE_TID();
            for (int item = bx * 512 + tid; item < (T / 32) * 128; item += G * 512) {
                const int cv = item & 127, tb = item >> 7; const int c0 = cv * 8, grp = cv >> 5, w = 2 << grp;
                const int r0 = tb * 32, s0 = r0 % SEQ;
                const bf16_t* up = QKU + 2048 + c0;
                float sum[8];
#pragma unroll
                for (int e = 0; e < 8; ++e) sum[e] = 0.f;
                for (int i = 1; i < w; ++i) if (s0 - i >= 0) { const u32x4 q = *(const u32x4*)(up + (size_t)(r0 - i) * NQKU);
                    sum[0] += bf_lo(q.x); sum[1] += bf_hi(q.x); sum[2] += bf_lo(q.y); sum[3] += bf_hi(q.y); sum[4] += bf_lo(q.z); sum[5] += bf_hi(q.z); sum[6] += bf_lo(q.w); sum[7] += bf_hi(q.w); }
                for (int i = 0; i < 32; ++i) {
                    const int s = s0 + i; const u32x4 q = *(const u32x4*)(up + (size_t)(r0 + i) * NQKU);
                    const float cu[8] = {bf_lo(q.x), bf_hi(q.x), bf_lo(q.y), bf_hi(q.y), bf_lo(q.z), bf_hi(q.z), bf_lo(q.w), bf_hi(q.w)};
                    const float ic = 1.0f / (float)((s + 1) < w ? (s + 1) : w);
                    float o[8];
#pragma unroll
                    for (int e = 0; e < 8; ++e) { sum[e] += cu[e]; o[e] = sum[e] * ic - cu[e]; }
                    u32x4 ow; ow.x = cvt_pk_bf16(o[0], o[1]); ow.y = cvt_pk_bf16(o[2], o[3]); ow.z = cvt_pk_bf16(o[4], o[5]); ow.w = cvt_pk_bf16(o[6], o[7]);
                    *(u32x4*)(PL + (size_t)(r0 + i) * PWD + c0) = ow;
                    if (s - w + 1 >= 0) { const u32x4 p = *(const u32x4*)(up + (size_t)(r0 + i - w + 1) * NQKU);
                        sum[0] -= bf_lo(p.x); sum[1] -= bf_hi(p.x); sum[2] -= bf_lo(p.y); sum[3] -= bf_hi(p.y); sum[4] -= bf_lo(p.z); sum[5] -= bf_hi(p.z); sum[6] -= bf_lo(p.w); sum[7] -= bf_hi(p.w); }
                }
            }
        }
        END_PH();
        if (IN_PH()) {
            pg8::Gemm g{PL, Wpl, 256, PWD, 256, 256}; pg8::StaticOrder S; S.init(T, PWD, G, bx); pg8::EpiStore E{CC, DM, AW, a.pool_scale + (size_t)l * PWD};
            pg8::gemm_phase<pg8::EpiStore, pg8::StaticOrder, true>(lds, g, S, E);
        }
        END_PH();
        if (IN_PH()) {
            pg8::Gemm g{CC, Wo, DM, DM, DM, 0}; pg8::StaticOrder S; S.init(T, DM, G, bx); pg8::EpiStore E{MY, DM, 0, nullptr};
            pg8::gemm_phase<pg8::EpiStore, pg8::StaticOrder, true>(lds, g, S, E);
        }
        END_PH();
        if (IN_PH()) {
            OPAQUE_TID();
            const float* xin = (l == 0) ? a.x : a.out;
            for (int m = gw; m < T; m += NGW) res_norm_row(MY + (size_t)m * DM, xin + (size_t)m * DM, a.out + (size_t)m * DM, a.post_mix_g + (size_t)l * DM, a.pre_ffn_g + (size_t)l * DM, Hb + (size_t)m * DM, lane);
        }
        END_PH();
        if (IN_PH()) {
            pg8::Gemm g{Hb, Wup, DM, DM, DM, 0}; pg8::StaticOrder S; S.init(T, FF2, G, bx);
            pg8::EpiUpConv E{Gb, a.conv_w + (size_t)l * 3 * FF2, a.conv_b + (size_t)l * FF2, HALO, lds + XCH_OFF};
            pg8::gemm_phase<pg8::EpiUpConv, pg8::StaticOrder, true>(lds, g, S, E);
        }
        END_PH();
        if (IN_PH()) {
            OPAQUE_TID();
            const float* cw = a.conv_w + (size_t)l * 3 * FF2; const float* cb = a.conv_b + (size_t)l * FF2;
            for (int item = bx * 512 + tid; item < 128 * 2 * FF; item += G * 512) {
                const int c = item % FF, rr = (item / FF) & 1, pm = item / (2 * FF);
                float o2[2];
#pragma unroll
                for (int hf = 0; hf < 2; ++hf) { const int oc = hf * FF + c;
                    const float* hc = HALO + (size_t)pm * 4 * FF2 + oc; const float* hp = HALO + (size_t)(pm - 1) * 4 * FF2 + oc;
                    const bool first = (pm % 64) == 0;
                    const float r254 = first ? 0.f : hp[2 * FF2], r255 = first ? 0.f : hp[3 * FF2], r0v = hc[0], r1v = hc[FF2];
                    const float p2 = rr == 0 ? r254 : r255, p1 = rr == 0 ? r255 : r0v, cu = rr == 0 ? r0v : r1v;
                    o2[hf] = cb[oc] + cw[oc] * p2 + cw[FF2 + oc] * p1 + cw[2 * FF2 + oc] * cu; }
                const float o = pg8::gelu_tanh(o2[0]) * o2[1];
                Gb[(size_t)(pm * 256 + rr) * FF + c] = (bf16_t)f2bf(o);
            }
        }
        END_PH();
        if (IN_PH()) {
            pg8::Gemm g{Gb, Wdn, FF, FF, FF, 0}; pg8::StaticOrder S; S.init(T, DM, G, bx); pg8::EpiStore E{MY, DM, 0, nullptr};
            pg8::gemm_phase<pg8::EpiStore, pg8::StaticOrder, true>(lds, g, S, E);
        }
        END_PH();
        if (IN_PH()) {
            OPAQUE_TID();
            const bool lastl = (l == DEPTH - 1);
            for (int m = gw; m < T; m += NGW) res_norm_row(MY + (size_t)m * DM, a.out + (size_t)m * DM, a.out + (size_t)m * DM, a.post_ffn_g + (size_t)l * DM,
                                                            lastl ? nullptr : a.pre_mix_g + (size_t)(l + 1) * DM, lastl ? nullptr : Hb + (size_t)m * DM, lane);
        }
        END_PH();
    }
#undef IN_PH
#undef END_PH
}

extern "C" void kernel_launch(void* const* d_in, const int* in_sizes, int n_in, void* d_out, int out_size, void* d_ws, size_t ws_size, hipStream_t stream) {
    static int grid = 0;
    if (grid == 0) {
        if (n_in != 14 || out_size != T * DM || ws_size < WS_END) { fprintf(stderr, "kernel_launch: unexpected problem (n_in %d out %d ws %zu)\n", n_in, out_size, ws_size); grid = -1; return; }
        int dev = 0, cus = 0, per_cu = 0;
        hipGetDevice(&dev); hipDeviceGetAttribute(&cus, hipDeviceAttributeMultiprocessorCount, dev);
        hipFuncSetAttribute((const void*)fwd_megakernel, hipFuncAttributeMaxDynamicSharedMemorySize, LDS_BYTES);
        hipOccupancyMaxActiveBlocksPerMultiprocessor(&per_cu, (const void*)fwd_megakernel, 512, LDS_BYTES);
        (void)hipGetLastError();
        if (per_cu < 1) { fprintf(stderr, "kernel_launch: occupancy query says %d blocks per CU\n", per_cu); per_cu = 1; }
        grid = cus;
    }
    if (grid < 0) return;
    Args a{};
    a.x = (const float*)d_in[0]; a.pre_mix_g = (const float*)d_in[1]; a.w_in = (const float*)d_in[2]; a.rel_bias = (const float*)d_in[3]; a.pool_w = (const float*)d_in[4];
    a.pool_scale = (const float*)d_in[5]; a.w_o = (const float*)d_in[6]; a.post_mix_g = (const float*)d_in[7]; a.pre_ffn_g = (const float*)d_in[8]; a.w_up = (const float*)d_in[9];
    a.conv_w = (const float*)d_in[10]; a.conv_b = (const float*)d_in[11]; a.w_down = (const float*)d_in[12]; a.post_ffn_g = (const float*)d_in[13];
    a.out = (float*)d_out; a.ws = (unsigned char*)d_ws; a.pad = 0;
#if MK_COOP
    a.ph_lo = 0; a.ph_hi = N_PHASES; a.coop = 1;
    void* args[] = {&a};
    hipError_t e = hipLaunchCooperativeKernel((const void*)fwd_megakernel, dim3(grid), dim3(512), args, LDS_BYTES, stream);
    if (e != hipSuccess) fprintf(stderr, "cooperative launch failed: %s (grid %d)\n", hipGetErrorString(e), grid);
#else
    for (int p = 0; p < N_PHASES; ++p) { a.ph_lo = p; a.ph_hi = p + 1; a.coop = 0; hipLaunchKernelGGL(fwd_megakernel, dim3(grid), dim3(512), LDS_BYTES, stream, a); }
#endif
}
```

```cpp
#include <hip/hip_runtime.h>
#include <hip/hip_cooperative_groups.h>
#include <cstdio>
#include <cstdint>
namespace cg = cooperative_groups;

#ifndef MK_COOP
#define MK_COOP 1
#endif

#define LAS __attribute__((address_space(3)))
typedef unsigned short bf16_t;
typedef short bf16x8 __attribute__((ext_vector_type(8)));
typedef float f32x4 __attribute__((ext_vector_type(4)));
typedef float f32x2 __attribute__((ext_vector_type(2)));
typedef unsigned u32x4 __attribute__((ext_vector_type(4)));
typedef unsigned u32x2 __attribute__((ext_vector_type(2)));

constexpr int BATCH = 2, SEQ = 16384, T = BATCH * SEQ, DM = 2048, DEPTH = 2;
constexpr int NH = 8, HD = 128, AW = 1024, PWD = 1024, FF = 5632, FF2 = 11264, INW = 4096, NQKU = 3072;
constexpr int NREL = 257;
constexpr float NORM_EPS = 1e-6f;
constexpr float LOG2E = 1.4426950408889634f;

__device__ __forceinline__ unsigned cvt_pk_bf16(float lo, float hi) { unsigned r; asm volatile("v_cvt_pk_bf16_f32 %0, %1, %2" : "=v"(r) : "v"(lo), "v"(hi)); return r; }
__device__ __forceinline__ float bf_lo(unsigned w) { return __uint_as_float(w << 16); }
__device__ __forceinline__ float bf_hi(unsigned w) { return __uint_as_float(w & 0xffff0000u); }

namespace pg8 {
constexpr int BM = 256, BK = 64, HALF = 128, HTB = HALF * BK * 2, STAGE_BYTES = 8 * HTB, NXCD = 8, WGM = 8;

__host__ __device__ __forceinline__ int lds_byte(int r, int c) { const int st = (r >> 4) * 2 + (c >> 5), rr = r & 15, cc = c & 31, ob = rr * 64 + cc * 2; return st * 1024 + (ob ^ (((ob >> 9) & 1) << 5)); }
__host__ __device__ __forceinline__ void stage_rc(int b, int& R, int& C) { const int st = b / 1024, sb = b % 1024, swz = sb ^ (((sb >> 9) & 1) << 5); R = (st >> 1) * 16 + swz / 64; C = (st & 1) * 32 + (swz % 64) / 2; }
__host__ __device__ __forceinline__ int perm32(int rho) { const int n = rho >> 4, i = rho & 15; return 8 * (i >> 2) + 4 * n + (i & 3); }

struct Unit { int pm, pn; };
struct Gemm { const bf16_t* A; const bf16_t* Bt; int K, lda, ldb, a_col_per_pn; };

struct StaticOrder {
    int nM, nN, nwg, G, c;
    __host__ __device__ void init(int M, int N, int G_, int c_) { nM = M / BM; nN = N / BM; nwg = nM * nN; G = G_; c = c_; }
    __host__ __device__ bool next(int i, Unit& u) const {
        const long L = (long)i * G + c; if (L >= nwg) return false;
        int wgid = (int)L; { const int q = nwg / NXCD, r = nwg % NXCD, xcd = wgid % NXCD, off = wgid / NXCD; wgid = (xcd < r ? xcd * (q + 1) : r * (q + 1) + (xcd - r) * q) + off; }
        const int nig = WGM * nN, gid = wgid / nig, fm = gid * WGM, gsz = (nM - fm) < WGM ? (nM - fm) : WGM;
        u.pm = fm + ((wgid % nig) % gsz); u.pn = (wgid % nig) / gsz; return true;
    }
};

struct EpiStore {
    static constexpr bool PERM = true;
    bf16_t* O; int ldc; int col_off; const float* colscale;
    __device__ __forceinline__ void operator()(const f32x4 (&acc)[2][2][4][2], const Unit& u, int wr, int wc, int fr, int fq) const {
        const int row0 = u.pm * BM + wr * 64 + fr; const int col0 = u.pn * BM + wc * 32 + 8 * fq;
        f32x4 sv[2][2];
#pragma unroll
        for (int bj = 0; bj < 2; ++bj)
#pragma unroll
            for (int n = 0; n < 2; ++n) sv[bj][n] = colscale ? *(const f32x4*)(colscale + col0 + bj * HALF + 4 * n) : (f32x4){1.f, 1.f, 1.f, 1.f};
#pragma unroll
        for (int ai = 0; ai < 2; ++ai)
#pragma unroll
            for (int m = 0; m < 4; ++m) { bf16_t* rowp = O + (size_t)(row0 + ai * HALF + m * 16) * ldc + col_off + col0;
#pragma unroll
                for (int bj = 0; bj < 2; ++bj) { f32x4 v0 = acc[ai][bj][m][0] * sv[bj][0], v1 = acc[ai][bj][m][1] * sv[bj][1];
                    u32x4 w; w.x = cvt_pk_bf16(v0[0], v0[1]); w.y = cvt_pk_bf16(v0[2], v0[3]); w.z = cvt_pk_bf16(v1[0], v1[1]); w.w = cvt_pk_bf16(v1[2], v1[3]);
                    *(u32x4*)(rowp + bj * HALF) = w; } }
    }
};

#define DPPF(old, src, ctrl) __builtin_bit_cast(float, __builtin_amdgcn_update_dpp(__builtin_bit_cast(int, (float)(old)), __builtin_bit_cast(int, (float)(src)), (ctrl), 0xf, 0xf, false))
__device__ __forceinline__ float gelu_tanh(float x) {
    const float u = x * (1.0f + 0.044715f * x * x);
    const float e = __builtin_amdgcn_exp2f(-2.3022081985f * u);
    return x * __builtin_amdgcn_rcpf(1.0f + e);
}
struct EpiUpConv {
    static constexpr bool PERM = true;
    bf16_t* G; const float* cw; const float* cb; float* halo; LAS unsigned char* xl;
    __device__ __forceinline__ void operator()(const f32x4 (&acc)[2][2][4][2], const Unit& u, int wr, int wc, int fr, int fq) const {
        LAS f32x4* X = (LAS f32x4*)xl;
        const int colg = u.pn * 128 + wc * 32 + 8 * fq;
        if (fr >= 14) {
#pragma unroll
            for (int ai = 0; ai < 2; ++ai)
#pragma unroll
                for (int bj = 0; bj < 2; ++bj)
#pragma unroll
                    for (int n = 0; n < 2; ++n) X[(((((ai * 2 + wr) * 4 + wc) * 2 + bj) * 2 + n) * 2 + (fr - 14)) * 4 + fq] = acc[ai][bj][3][n];
            if (wr == 1) {
#pragma unroll
                for (int bj = 0; bj < 2; ++bj)
#pragma unroll
                    for (int n = 0; n < 2; ++n) *(f32x4*)(halo + ((size_t)u.pm * 4 + 2 + (fr - 14)) * FF2 + bj * FF + colg + 4 * n) = acc[1][bj][3][n];
            }
        }
        if (wr == 0 && fr < 2) {
#pragma unroll
            for (int bj = 0; bj < 2; ++bj)
#pragma unroll
                for (int n = 0; n < 2; ++n) *(f32x4*)(halo + ((size_t)u.pm * 4 + fr) * FF2 + bj * FF + colg + 4 * n) = acc[0][bj][0][n];
        }
        asm volatile("s_waitcnt lgkmcnt(0)" ::: "memory"); __builtin_amdgcn_s_barrier(); asm volatile("" ::: "memory");
#pragma unroll
        for (int n = 0; n < 2; ++n) {
            f32x4 w0[2], w1[2], w2[2], bb[2];
#pragma unroll
            for (int bj = 0; bj < 2; ++bj) { const int oc = bj * FF + colg + 4 * n;
                w0[bj] = *(const f32x4*)(cw + oc); w1[bj] = *(const f32x4*)(cw + FF2 + oc); w2[bj] = *(const f32x4*)(cw + 2 * FF2 + oc); bb[bj] = *(const f32x4*)(cb + oc); }
#pragma unroll
            for (int ai = 0; ai < 2; ++ai) {
                const int seg = ai * 2 + wr;
                f32x4 vp[2];
#pragma unroll
                for (int bj = 0; bj < 2; ++bj) { vp[bj] = (f32x4){0.f, 0.f, 0.f, 0.f};
                    if (seg > 0 && fr >= 14) vp[bj] = X[((((((seg - 1) * 4 + wc) * 2 + bj) * 2 + n) * 2 + (fr - 14)) * 4) + fq]; }
#pragma unroll
                for (int m = 0; m < 4; ++m) {
                    f32x4 cv[2];
#pragma unroll
                    for (int bj = 0; bj < 2; ++bj) { const f32x4 cur = acc[ai][bj][m][n]; const f32x4 prv = (m == 0) ? vp[bj] : acc[ai][bj][m == 0 ? 0 : m - 1][n];
#pragma unroll
                        for (int j = 0; j < 4; ++j) { const float t1 = DPPF(0.f, prv[j], 0x121), p1 = DPPF(t1, cur[j], 0x111); const float t2 = DPPF(0.f, prv[j], 0x122), p2 = DPPF(t2, cur[j], 0x112);
                            cv[bj][j] = bb[bj][j] + w0[bj][j] * p2 + w1[bj][j] * p1 + w2[bj][j] * cur[j]; } }
                    f32x4 o;
#pragma unroll
                    for (int j = 0; j < 4; ++j) o[j] = gelu_tanh(cv[0][j]) * cv[1][j];
                    u32x2 w; w.x = cvt_pk_bf16(o[0], o[1]); w.y = cvt_pk_bf16(o[2], o[3]);
                    *(u32x2*)(G + (size_t)(u.pm * BM + ai * HALF + wr * 64 + m * 16 + fr) * FF + colg + 4 * n) = w;
                }
            }
        }
    }
};

template <class Epi, class Sched, bool ALIGN_EPI = false>
__device__ __forceinline__ void gemm_phase(LAS unsigned char* lds, const Gemm g, const Sched& S, const Epi& E) {
    int tid_ = threadIdx.x; asm volatile("" : "+v"(tid_));
    const int tid = tid_, wid = __builtin_amdgcn_readfirstlane(tid >> 6), lane = tid & 63, wr = wid >> 2, wc = wid & 3, fr = lane & 15, fq = lane >> 4;
    const int K = g.K, nt = K / BK;
    unsigned voffA[2], voffB[2];
#pragma unroll
    for (int i = 0; i < 2; ++i) { int R, C; stage_rc(tid * 16 + i * 8192, R, C); const int Rb = Epi::PERM ? ((R & ~31) + perm32(R & 31)) : R;
        voffA[i] = (unsigned)(R * g.lda + C) * 2u; voffB[i] = (unsigned)(Rb * g.ldb + C) * 2u; }
    const size_t kstep = (size_t)(BK * 2);
    const size_t hstepA = (size_t)HALF * g.lda * 2, hstepB = (size_t)HALF * g.ldb * 2;
    const unsigned ldsw = (unsigned)wid * 1024u;
    const int aoff = lds_byte(wr * 64 + fr, fq * 8), boff = lds_byte(wc * 32 + fr, fq * 8);
#define PG8_SA(b, h) (((b) * 2 + (h)) * HTB)
#define PG8_SB(b, h) ((4 + (b) * 2 + (h)) * HTB)
#define PG8_STAGE(bufoff, gbase, voff) do { _Pragma("unroll") for (int _i = 0; _i < 2; ++_i) \
        __builtin_amdgcn_global_load_lds((const unsigned*)((const char*)(gbase) + (voff)[_i]), (LAS unsigned*)(lds + (bufoff) + ldsw + _i * 8192), 16, 0, 0); } while (0)
#define PG8_LDA(dst, b, h) do { _Pragma("unroll") for (int m = 0; m < 4; ++m) _Pragma("unroll") for (int k = 0; k < 2; ++k) dst[m][k] = *(const LAS bf16x8*)(lds + PG8_SA(b, h) + aoff + m * 2048 + k * 1024); } while (0)
#define PG8_LDB(dst, b, h) do { _Pragma("unroll") for (int n = 0; n < 2; ++n) _Pragma("unroll") for (int k = 0; k < 2; ++k) dst[n][k] = *(const LAS bf16x8*)(lds + PG8_SB(b, h) + boff + n * 2048 + k * 1024); } while (0)
#define PG8_MMA(ai, bj, At, Bt) do { __builtin_amdgcn_s_setprio(1); _Pragma("unroll") for (int m = 0; m < 4; ++m) _Pragma("unroll") for (int n = 0; n < 2; ++n) _Pragma("unroll") for (int k = 0; k < 2; ++k) \
        acc[ai][bj][m][n] = __builtin_amdgcn_mfma_f32_16x16x32_bf16(Bt[n][k], At[m][k], acc[ai][bj][m][n], 0, 0, 0); __builtin_amdgcn_s_setprio(0); } while (0)
#define PG8_WAIT_V(n) asm volatile("s_waitcnt vmcnt(" #n ")" ::: "memory")
#define PG8_WAIT_L(n) asm volatile("s_waitcnt lgkmcnt(" #n ")" ::: "memory")
#define PG8_BAR __builtin_amdgcn_s_barrier()
#define PG8_SCHED __builtin_amdgcn_sched_barrier(0)
#define PG8_UA(u) ((const char*)g.A + (size_t)(u).pm * 2 * hstepA + (size_t)(u).pn * (size_t)g.a_col_per_pn * 2)
#define PG8_UB(u) ((const char*)g.Bt + (size_t)(u).pn * 2 * hstepB)
    Unit cur, nxt; int ui = 0;
    if (!S.next(0, cur)) return;
    f32x4 acc[2][2][4][2];
#pragma unroll
    for (int a = 0; a < 2; ++a)
#pragma unroll
        for (int b = 0; b < 2; ++b)
#pragma unroll
            for (int m = 0; m < 4; ++m)
#pragma unroll
                for (int n = 0; n < 2; ++n) acc[a][b][m][n] = (f32x4){0.f, 0.f, 0.f, 0.f};
    bf16x8 At[4][2], B0[2][2], B1[2][2];
    const char* cA = PG8_UA(cur); const char* cB = PG8_UB(cur);
    PG8_STAGE(PG8_SB(0, 0), cB, voffB); PG8_STAGE(PG8_SB(0, 1), cB + hstepB, voffB); PG8_STAGE(PG8_SA(0, 0), cA, voffA); PG8_STAGE(PG8_SA(0, 1), cA + hstepA, voffA);
    if (wr == 1) PG8_BAR;
    PG8_WAIT_V(2); PG8_BAR;
    PG8_STAGE(PG8_SB(1, 0), cB + kstep, voffB); PG8_STAGE(PG8_SA(1, 0), cA + kstep, voffA); PG8_STAGE(PG8_SB(1, 1), cB + hstepB + kstep, voffB);
    PG8_WAIT_V(6); PG8_BAR;
    for (;;) {
        const bool has_next = S.next(ui + 1, nxt);
        const char* nA = has_next ? PG8_UA(nxt) : cA; const char* nB = has_next ? PG8_UB(nxt) : cB;
        for (int t = 0; t < nt; t += 2) {
            const bool last = (t == nt - 2);
            const char* a1 = cA + (size_t)(t + 1) * kstep;
            const char* a2 = last ? nA : cA + (size_t)(t + 2) * kstep; const char* b2 = last ? nB : cB + (size_t)(t + 2) * kstep;
            const char* a3 = a2 + kstep; const char* b3 = b2 + kstep;
            PG8_LDB(B0, 0, 0); PG8_LDB(B1, 0, 1); PG8_SCHED; PG8_LDA(At, 0, 0); PG8_STAGE(PG8_SA(1, 1), a1 + hstepA, voffA);
            PG8_WAIT_V(8); PG8_WAIT_L(0); PG8_BAR; PG8_MMA(0, 0, At, B0); PG8_MMA(0, 1, At, B1); PG8_BAR; PG8_SCHED;
            PG8_LDA(At, 0, 1); PG8_STAGE(PG8_SB(0, 0), b2, voffB); PG8_STAGE(PG8_SB(0, 1), b2 + hstepB, voffB); PG8_STAGE(PG8_SA(0, 0), a2, voffA);
            PG8_WAIT_V(8); PG8_WAIT_L(0); PG8_BAR; PG8_MMA(1, 0, At, B0); PG8_MMA(1, 1, At, B1); PG8_BAR; PG8_SCHED;
            PG8_LDB(B0, 1, 0); PG8_LDB(B1, 1, 1); PG8_SCHED; PG8_LDA(At, 1, 0); PG8_STAGE(PG8_SA(0, 1), a2 + hstepA, voffA);
            PG8_WAIT_V(8); PG8_WAIT_L(0); PG8_BAR; PG8_MMA(0, 0, At, B0); PG8_MMA(0, 1, At, B1); PG8_BAR; PG8_SCHED;
            PG8_LDA(At, 1, 1); PG8_STAGE(PG8_SB(1, 0), b3, voffB); PG8_STAGE(PG8_SB(1, 1), b3 + hstepB, voffB); PG8_STAGE(PG8_SA(1, 0), a3, voffA);
            PG8_WAIT_V(8); PG8_WAIT_L(0); PG8_BAR; PG8_MMA(1, 0, At, B0); PG8_MMA(1, 1, At, B1); PG8_BAR; PG8_SCHED;
        }
        if constexpr (ALIGN_EPI) { if (wr == 0) PG8_BAR; }
        E(acc, cur, wr, wc, fr, fq);
        if (!has_next) break;
#pragma unroll
        for (int a = 0; a < 2; ++a)
#pragma unroll
            for (int b = 0; b < 2; ++b)
#pragma unroll
                for (int m = 0; m < 4; ++m)
#pragma unroll
                    for (int n = 0; n < 2; ++n) acc[a][b][m][n] = (f32x4){0.f, 0.f, 0.f, 0.f};
        cur = nxt; cA = nA; cB = nB; ++ui;
        if constexpr (ALIGN_EPI) { if (wr == 1) PG8_BAR; }
    }
    PG8_WAIT_V(0);
    if constexpr (!ALIGN_EPI) { if (wr == 0) PG8_BAR; }
    PG8_BAR;
#undef PG8_SA
#undef PG8_SB
#undef PG8_STAGE
#undef PG8_LDA
#undef PG8_LDB
#undef PG8_MMA
#undef PG8_WAIT_V
#undef PG8_WAIT_L
#undef PG8_BAR
#undef PG8_SCHED
#undef PG8_UA
#undef PG8_UB
}
}

constexpr size_t MiB = 1u << 20;
constexpr size_t WS_W = 1 * MiB, W_LAYER = 91 * MiB;
constexpr size_t WO_IN = 0, WO_O = 16 * MiB, WO_UP = 24 * MiB, WO_DOWN = 68 * MiB, WO_POOL = 90 * MiB;
constexpr size_t WS_H = 183 * MiB;
constexpr size_t WS_QKU = 311 * MiB, WS_VT = 503 * MiB, WS_CC = 567 * MiB;
constexpr size_t WS_G = 311 * MiB;
constexpr size_t WS_POOLED = 695 * MiB;
constexpr size_t WS_MY = 759 * MiB;
constexpr size_t WS_HALO = 887 * MiB;
constexpr size_t WS_END = 909 * MiB;

constexpr int RING_BYTES = 131072, XCH_OFF = RING_BYTES, XB_ST_OFF = XCH_OFF + 12288, LDS_BYTES = 147456;

struct Args {
    const float* x; const float* pre_mix_g; const float* w_in; const float* rel_bias; const float* pool_w; const float* pool_scale; const float* w_o;
    const float* post_mix_g; const float* pre_ffn_g; const float* w_up; const float* conv_w; const float* conv_b; const float* w_down; const float* post_ffn_g;
    float* out; unsigned char* ws; int ph_lo, ph_hi, coop, pad;
};

__device__ __forceinline__ float wave_sum(float v) {
#pragma unroll
    for (int o = 1; o < 64; o <<= 1) v += __shfl_xor(v, o);
    return v;
}
__device__ __forceinline__ unsigned f2bf(float f) { unsigned u = __builtin_bit_cast(unsigned, f); return (u + 0x7fffu + ((u >> 16) & 1u)) >> 16; }
__device__ __forceinline__ unsigned pk2(float lo, float hi) { return f2bf(lo) | (f2bf(hi) << 16); }

__device__ __forceinline__ void transpose_item(const float* W, int N, bf16_t* WT, int ldk, int k0, int n0, int drow0, LAS float* scr, int lane) {
#pragma unroll 8
    for (int i = 0; i < 32; ++i) { const int kk = 2 * i + (lane >> 5); scr[kk * 33 + (lane & 31)] = W[(size_t)(k0 + kk) * N + n0 + (lane & 31)]; }
    asm volatile("s_waitcnt lgkmcnt(0)" ::: "memory");
    const int c = lane & 7;
#pragma unroll
    for (int j = 0; j < 4; ++j) { const int n = (lane >> 3) + 8 * j; const LAS float* s = scr + (8 * c) * 33 + n;
        u32x4 o; o.x = pk2(s[0 * 33], s[1 * 33]); o.y = pk2(s[2 * 33], s[3 * 33]); o.z = pk2(s[4 * 33], s[5 * 33]); o.w = pk2(s[6 * 33], s[7 * 33]);
        *(u32x4*)(WT + (size_t)(drow0 + n) * ldk + k0 + 8 * c) = o; }
    asm volatile("s_waitcnt lgkmcnt(0)" ::: "memory");
}

__device__ __forceinline__ void rms_row_to_bf16(const float* xrow, const float* g, bf16_t* orow, int lane) {
    f32x4 v[8]; float s = 0.f;
#pragma unroll
    for (int j = 0; j < 4; ++j) { v[2 * j] = *(const f32x4*)(xrow + 8 * (lane + 64 * j)); v[2 * j + 1] = *(const f32x4*)(xrow + 8 * (lane + 64 * j) + 4); }
#pragma unroll
    for (int j = 0; j < 8; ++j) s += (v[j].x * v[j].x + v[j].y * v[j].y) + (v[j].z * v[j].z + v[j].w * v[j].w);
    const float rstd = 1.0f / sqrtf(wave_sum(s) * (1.0f / DM) + NORM_EPS);
#pragma unroll
    for (int j = 0; j < 4; ++j) { const int c = 8 * (lane + 64 * j); const f32x4 g0 = *(const f32x4*)(g + c), g1 = *(const f32x4*)(g + c + 4); const f32x4 a = v[2 * j] * rstd * g0, b = v[2 * j + 1] * rstd * g1;
        u32x4 w; w.x = cvt_pk_bf16(a.x, a.y); w.y = cvt_pk_bf16(a.z, a.w); w.z = cvt_pk_bf16(b.x, b.y); w.w = cvt_pk_bf16(b.z, b.w); *(u32x4*)(orow + c) = w; }
}

__device__ __forceinline__ void res_norm_row(const bf16_t* mrow, const float* xin, float* xout, const float* g1, const float* g2, bf16_t* hrow, int lane) {
    f32x4 v[8]; float s = 0.f;
#pragma unroll
    for (int j = 0; j < 4; ++j) { const u32x4 w = *(const u32x4*)(mrow + 8 * (lane + 64 * j));
        v[2 * j] = (f32x4){bf_lo(w.x), bf_hi(w.x), bf_lo(w.y), bf_hi(w.y)}; v[2 * j + 1] = (f32x4){bf_lo(w.z), bf_hi(w.z), bf_lo(w.w), bf_hi(w.w)}; }
#pragma unroll
    for (int j = 0; j < 8; ++j) s += (v[j].x * v[j].x + v[j].y * v[j].y) + (v[j].z * v[j].z + v[j].w * v[j].w);
    const float rstd = 1.0f / sqrtf(wave_sum(s) * (1.0f / DM) + NORM_EPS);
    float s2 = 0.f;
#pragma unroll
    for (int j = 0; j < 8; ++j) { const int c = 8 * (lane + 64 * (j >> 1)) + 4 * (j & 1); const f32x4 gg = *(const f32x4*)(g1 + c); const f32x4 xi = *(const f32x4*)(xin + c);
        v[j] = xi + v[j] * rstd * gg; *(f32x4*)(xout + c) = v[j]; s2 += (v[j].x * v[j].x + v[j].y * v[j].y) + (v[j].z * v[j].z + v[j].w * v[j].w); }
    if (hrow) {
        const float rstd2 = 1.0f / sqrtf(wave_sum(s2) * (1.0f / DM) + NORM_EPS);
#pragma unroll
        for (int j = 0; j < 4; ++j) { const int c = 8 * (lane + 64 * j); const f32x4 g0 = *(const f32x4*)(g2 + c), g1v = *(const f32x4*)(g2 + c + 4); const f32x4 a = v[2 * j] * rstd2 * g0, b = v[2 * j + 1] * rstd2 * g1v;
            u32x4 w; w.x = cvt_pk_bf16(a.x, a.y); w.y = cvt_pk_bf16(a.z, a.w); w.z = cvt_pk_bf16(b.x, b.y); w.w = cvt_pk_bf16(b.z, b.w); *(u32x4*)(hrow + c) = w; }
    }
}

constexpr int AT_BT = 0, AT_BUF = 8448, AT_KSTR = 272, AT_VSTR = 144, AT_VOFF = 64 * AT_KSTR, AT_BUFSZ = AT_VOFF + 128 * AT_VSTR;
static_assert(AT_BUF + 2 * AT_BUFSZ <= RING_BYTES, "attention LDS");
__device__ __forceinline__ void attn_phase(LAS unsigned char* lds, const bf16_t* QKU, const bf16_t* VT, bf16_t* CC, const float* relb, int vcu, int G) {
    int tid_ = threadIdx.x; asm volatile("" : "+v"(tid_));
    const int tid = tid_, wid = __builtin_amdgcn_readfirstlane(tid >> 6), lane = tid & 63, fr = lane & 15, fq = lane >> 4;
    LAS float* bt = (LAS float*)(lds + AT_BT);
    for (int i = tid; i < NH * NREL; i += 512) bt[(i / NREL) * 260 + (i % NREL)] = relb[i] * LOG2E;
    __syncthreads();
    const float SC = 0.08838834764831845f * LOG2E;
    for (int unit = vcu; unit < BATCH * NH * 128; unit += G) {
        const int bh = unit >> 7, np = unit & 127, b = bh >> 3, h = bh & 7;
        const int qc = 2 * np + (wid >> 2), ql = (wid & 3) * 16 + fr;
        const size_t trow = (size_t)b * SEQ + qc * 64 + ql;
        bf16x8 Qf[4];
#pragma unroll
        for (int ds = 0; ds < 4; ++ds) Qf[ds] = *(const bf16x8*)(QKU + trow * NQKU + h * HD + 32 * ds + 8 * fq);
        const int kc_lo = (2 * np - 8) > 0 ? (2 * np - 8) : 0, kc_hi = 2 * np + 1;
        const int my_lo = (qc - 8) > 0 ? (qc - 8) : 0, my_hi = qc;
        f32x4 O[8];
#pragma unroll
        for (int d = 0; d < 8; ++d) O[d] = (f32x4){0.f, 0.f, 0.f, 0.f};
        float mrun = -1e30f, lrun = 0.f;
        const LAS float* bth = bt + h * 260;
        const int kr0 = tid >> 4, kc16 = tid & 15, vr0 = tid >> 3, vc16 = tid & 7;
        const bf16_t* ksrc = QKU + ((size_t)b * SEQ + kr0) * NQKU + AW + h * HD + kc16 * 8;
        const bf16_t* vsrc = VT + (size_t)(h * HD + vr0) * T + (size_t)b * SEQ + vc16 * 8;
        const int kdst = kr0 * AT_KSTR + kc16 * 16, vdst = AT_VOFF + vr0 * AT_VSTR + vc16 * 16;
        u32x4 kreg[2], vreg[2];
#define AT_LOAD(kc) do { kreg[0] = *(const u32x4*)(ksrc + (size_t)(kc) * 64 * NQKU); kreg[1] = *(const u32x4*)(ksrc + ((size_t)(kc) * 64 + 32) * NQKU); \
                         vreg[0] = *(const u32x4*)(vsrc + (size_t)(kc) * 64); vreg[1] = *(const u32x4*)(vsrc + (size_t)64 * T + (size_t)(kc) * 64); } while (0)
#define AT_STORE(buf) do { LAS unsigned char* bb_ = lds + AT_BUF + (buf) * AT_BUFSZ; *(LAS u32x4*)(bb_ + kdst) = kreg[0]; *(LAS u32x4*)(bb_ + kdst + 32 * AT_KSTR) = kreg[1]; \
                           *(LAS u32x4*)(bb_ + vdst) = vreg[0]; *(LAS u32x4*)(bb_ + vdst + 64 * AT_VSTR) = vreg[1]; } while (0)
        AT_LOAD(kc_lo); AT_STORE(0);
        __syncthreads();
        for (int kc = kc_lo; kc <= kc_hi; ++kc) {
            const int cur = (kc - kc_lo) & 1;
            if (kc < kc_hi) AT_LOAD(kc + 1);
            if (kc >= my_lo && kc <= my_hi) {
                const LAS unsigned char* Kb = lds + AT_BUF + cur * AT_BUFSZ; const LAS unsigned char* Vb = Kb + AT_VOFF;
                f32x4 s[4];
#pragma unroll
                for (int kb = 0; kb < 4; ++kb) { s[kb] = (f32x4){0.f, 0.f, 0.f, 0.f};
                    const int krow = 32 * (kb >> 1) + 8 * (fr >> 2) + 4 * (kb & 1) + (fr & 3);
#pragma unroll
                    for (int ds = 0; ds < 4; ++ds) { const bf16x8 kf = *(const LAS bf16x8*)(Kb + krow * AT_KSTR + (32 * ds + 8 * fq) * 2);
                        s[kb] = __builtin_amdgcn_mfma_f32_16x16x32_bf16(kf, Qf[ds], s[kb], 0, 0, 0); } }
                const int dch = qc - kc;
                if (dch >= 3) { const float cbias = bth[256];
#pragma unroll
                    for (int kb = 0; kb < 4; ++kb) s[kb] = s[kb] * SC + cbias;
                } else {
                    const int rb = 64 * dch + ql - 8 * fq + 128;
#pragma unroll
                    for (int kb = 0; kb < 4; ++kb)
#pragma unroll
                        for (int j = 0; j < 4; ++j) { int idx = rb - (32 * (kb >> 1) + 4 * (kb & 1) + j); idx = idx > 256 ? 256 : idx; s[kb][j] = s[kb][j] * SC + bth[idx]; }
                }
                float mx = s[0][0];
#pragma unroll
                for (int kb = 0; kb < 4; ++kb)
#pragma unroll
                    for (int j = 0; j < 4; ++j) mx = fmaxf(mx, s[kb][j]);
                mx = fmaxf(mx, __shfl_xor(mx, 16)); mx = fmaxf(mx, __shfl_xor(mx, 32));
                const float mnew = fmaxf(mrun, mx), alpha = __builtin_amdgcn_exp2f(mrun - mnew); mrun = mnew;
                float ps = 0.f;
#pragma unroll
                for (int kb = 0; kb < 4; ++kb)
#pragma unroll
                    for (int j = 0; j < 4; ++j) { s[kb][j] = __builtin_amdgcn_exp2f(s[kb][j] - mnew); ps += s[kb][j]; }
                lrun = lrun * alpha + ps;
#pragma unroll
                for (int d = 0; d < 8; ++d) O[d] = O[d] * alpha;
                bf16x8 Pf[2];
#pragma unroll
                for (int ks = 0; ks < 2; ++ks) { u32x4 w; w.x = cvt_pk_bf16(s[2 * ks][0], s[2 * ks][1]); w.y = cvt_pk_bf16(s[2 * ks][2], s[2 * ks][3]);
                    w.z = cvt_pk_bf16(s[2 * ks + 1][0], s[2 * ks + 1][1]); w.w = cvt_pk_bf16(s[2 * ks + 1][2], s[2 * ks + 1][3]); Pf[ks] = __builtin_bit_cast(bf16x8, w); }
#pragma unroll
                for (int d = 0; d < 8; ++d)
#pragma unroll
                    for (int ks = 0; ks < 2; ++ks) { const bf16x8 vf = *(const LAS bf16x8*)(Vb + (16 * d + fr) * AT_VSTR + (32 * ks + 8 * fq) * 2);
                        O[d] = __builtin_amdgcn_mfma_f32_16x16x32_bf16(vf, Pf[ks], O[d], 0, 0, 0); }
            }
            if (kc < kc_hi) AT_STORE(cur ^ 1);
            __syncthreads();
        }
#undef AT_LOAD
#undef AT_STORE
        float lt = lrun; lt += __shfl_xor(lt, 16); lt += __shfl_xor(lt, 32);
        const float inv = 1.0f / lt;
        bf16_t* op = CC + trow * DM + h * HD + 4 * fq;
#pragma unroll
        for (int d = 0; d < 8; ++d) { const f32x4 o = O[d] * inv; u32x2 w; w.x = cvt_pk_bf16(o[0], o[1]); w.y = cvt_pk_bf16(o[2], o[3]); *(u32x2*)(op + 16 * d) = w; }
    }
}

#define XB_TMO      128
#define XB_XCNT(j)  (256  + 64 * (j))
#define XB_XSUB(j)  (1280 + 64 * (j))
#define XB_XGEN(j)  (2304 + 64 * (j))
#define XB_TOP      3328
#define XB_TOPGEN   3392
#define XCD_BAR_WORDS 3456
#define XB_SPIN_CAP (1u << 18)
__device__ __forceinline__ unsigned xb_ld(unsigned* p)              { return __hip_atomic_load(p, __ATOMIC_RELAXED, __HIP_MEMORY_SCOPE_AGENT); }
__device__ __forceinline__ unsigned xb_add(unsigned* p, unsigned v) { return __hip_atomic_fetch_add(p, v, __ATOMIC_RELAXED, __HIP_MEMORY_SCOPE_AGENT); }
__device__ __forceinline__ unsigned xb_xcc_id() { return (unsigned)__builtin_amdgcn_s_getreg((3 << 11) | 20) & 0xFu; }
#define XB_SPIN(cond, bar) do { unsigned _sp = 0; while (cond) { __builtin_amdgcn_s_sleep(1); \
    if ((++_sp & 255u) == 0u) { if (xb_ld(&(bar)[XB_TMO])) break; if (_sp > XB_SPIN_CAP) { atomicAdd(&(bar)[XB_TMO], 1u); break; } } } } while (0)
struct XcdBarrier { unsigned* bar; unsigned x; volatile LAS unsigned* st; };
__device__ __forceinline__ XcdBarrier xcd_barrier_post(unsigned* bar, volatile LAS unsigned* st) {
    XcdBarrier b; b.bar = bar; b.x = xb_xcc_id(); b.st = st;
    if (threadIdx.x == 0) (void)xb_add(&bar[XB_XCNT(b.x)], 1u);
    return b;
}
__device__ __forceinline__ void xcd_barrier_complete(unsigned* bar, unsigned x, unsigned& nloc, unsigned& nx) {
    const unsigned G = gridDim.x * gridDim.y * gridDim.z;
    unsigned sum, cnt, mine, sp = 0u;
    for (;;) {
        sum = 0u; cnt = 0u; mine = 0u;
#pragma unroll
        for (unsigned j = 0; j < 16; ++j) { const unsigned c = xb_ld(&bar[XB_XCNT(j)]); sum += c; cnt += (c > 0u) ? 1u : 0u; mine = (j == x) ? c : mine; }
        if (sum == G) break;
        __builtin_amdgcn_s_sleep(1);
        if ((++sp & 255u) == 0u) { if (xb_ld(&bar[XB_TMO])) break; if (sp > XB_SPIN_CAP) { atomicAdd(&bar[XB_TMO], 1u); break; } }
    }
    nloc = mine > 0u ? mine : 1u; nx = cnt > 0u ? cnt : 1u;
}
__device__ __forceinline__ void xcd_barrier(const XcdBarrier& b) {
    asm volatile("s_waitcnt vmcnt(0)" ::: "memory");
    __syncthreads();
    if (threadIdx.x == 0) {
        unsigned* bar = b.bar;
        __builtin_amdgcn_s_waitcnt(0);
        unsigned nloc = b.st[0], nx = b.st[1];
        if (nloc == 0u) { xcd_barrier_complete(bar, b.x, nloc, nx); b.st[0] = nloc; b.st[1] = nx; }
        const unsigned old = xb_add(&bar[XB_XSUB(b.x)], 1u);
        const unsigned gen = old / nloc;
        if (old + 1u == (gen + 1u) * nloc) {
            __builtin_amdgcn_fence(__ATOMIC_RELEASE, "agent");
            asm volatile("s_waitcnt vmcnt(0)" ::: "memory");
            const unsigned og = xb_add(&bar[XB_TOP], 1u);
            const unsigned tg = og / nx;
            if (og + 1u == (tg + 1u) * nx) xb_add(&bar[XB_TOPGEN], 1u);
            else XB_SPIN(xb_ld(&bar[XB_TOPGEN]) == tg, bar);
            __builtin_amdgcn_fence(__ATOMIC_ACQUIRE, "agent");
            xb_add(&bar[XB_XGEN(b.x)], 1u);
            asm volatile("s_waitcnt vmcnt(0)" ::: "memory");
        } else {
            XB_SPIN(xb_ld(&bar[XB_XGEN(b.x)]) == gen, bar);
            __builtin_amdgcn_fence(__ATOMIC_ACQUIRE, "agent");
            asm volatile("s_waitcnt vmcnt(0)" ::: "memory");
        }
    }
    __syncthreads();
}

constexpr int N_PHASES = 1 + 9 * DEPTH;
__global__ void __launch_bounds__(512, 2) fwd_megakernel(Args a) {
    extern __shared__ __attribute__((aligned(16))) unsigned char lds_raw[];
    LAS unsigned char* lds = (LAS unsigned char*)lds_raw;
    const int wave = __builtin_amdgcn_readfirstlane((int)threadIdx.x >> 6);
    const int G = gridDim.x, bx = blockIdx.x;
#define OPAQUE_TID() int tid = threadIdx.x; asm volatile("" : "+v"(tid)); const int lane = tid & 63; (void)lane
    const int vcu = (G % 8 == 0) ? (bx % 8) * (G / 8) + bx / 8 : bx;
    const int gw = vcu * 8 + wave, NGW = G * 8;
    unsigned char* ws = a.ws;
    bf16_t* Hb = (bf16_t*)(ws + WS_H); bf16_t* QKU = (bf16_t*)(ws + WS_QKU); bf16_t* VT = (bf16_t*)(ws + WS_VT); bf16_t* CC = (bf16_t*)(ws + WS_CC);
    bf16_t* Gb = (bf16_t*)(ws + WS_G); bf16_t* PL = (bf16_t*)(ws + WS_POOLED); bf16_t* MY = (bf16_t*)(ws + WS_MY); float* HALO = (float*)(ws + WS_HALO);
    const int lo = a.ph_lo, hi = a.ph_hi;
    int ph = 0;
#define IN_PH() (lo <= ph && ph < hi)
#define END_PH() do { ++ph; if (a.coop && lo < ph && ph < hi) { if (ph == 1) { cg::this_grid().sync(); xbar = xcd_barrier_post(barw, (volatile LAS unsigned*)(lds + XB_ST_OFF)); } else xcd_barrier(xbar); } } while (0)
    unsigned* barw = (unsigned*)ws;
    XcdBarrier xbar; xbar.bar = barw; xbar.x = 0; xbar.st = (volatile LAS unsigned*)(lds + XB_ST_OFF);
    if (a.coop) { if (bx == 0) for (int i = threadIdx.x; i < XCD_BAR_WORDS; i += 512) __hip_atomic_store(barw + i, 0u, __ATOMIC_RELAXED, __HIP_MEMORY_SCOPE_AGENT);
        if (threadIdx.x < 2) ((volatile LAS unsigned*)(lds + XB_ST_OFF))[threadIdx.x] = 0u; __syncthreads(); }

    if (IN_PH()) {
        OPAQUE_TID();
        LAS float* scr = (LAS float*)(lds + wave * 16384);
        constexpr int I_IN = (DM / 64) * (INW / 32), I_O = (DM / 64) * (DM / 32), I_UP = (DM / 64) * (FF2 / 32), I_DN = (FF / 64) * (DM / 32), I_PL = 4 * (256 / 64) * (256 / 32);
        constexpr int I_LAYER = I_IN + I_O + I_UP + I_DN + I_PL;
        for (int it = gw; it < DEPTH * I_LAYER; it += NGW) {
            const int l = it / I_LAYER; int r = it % I_LAYER;
            unsigned char* wl = ws + WS_W + (size_t)l * W_LAYER;
            if (r < I_IN) { const int nblk = INW / 32, kb = r / nblk, nb = r % nblk, n0 = 32 * nb;
                const int drow = n0 < 2048 ? n0 : (n0 < 3072 ? n0 + 1024 : n0 - 1024);
                transpose_item(a.w_in + (size_t)l * DM * INW, INW, (bf16_t*)(wl + WO_IN), DM, 64 * kb, n0, drow, scr, lane); continue; } r -= I_IN;
            if (r < I_O) { const int nblk = DM / 32, kb = r / nblk, nb = r % nblk;
                transpose_item(a.w_o + (size_t)l * DM * DM, DM, (bf16_t*)(wl + WO_O), DM, 64 * kb, 32 * nb, 32 * nb, scr, lane); continue; } r -= I_O;
            if (r < I_UP) { const int nblk = FF2 / 32, kb = r / nblk, nb = r % nblk, n0 = 32 * nb;
                const int half = n0 >= FF ? 1 : 0, cc = n0 - half * FF; const int drow = 256 * (cc >> 7) + 128 * half + (cc & 127);
                transpose_item(a.w_up + (size_t)l * DM * FF2, FF2, (bf16_t*)(wl + WO_UP), DM, 64 * kb, n0, drow, scr, lane); continue; } r -= I_UP;
            if (r < I_DN) { const int nblk = DM / 32, kb = r / nblk, nb = r % nblk;
                transpose_item(a.w_down + (size_t)l * FF * DM, DM, (bf16_t*)(wl + WO_DOWN), FF, 64 * kb, 32 * nb, 32 * nb, scr, lane); continue; } r -= I_DN;
            { const int gidx = r / 32, rr = r % 32, kb = rr / 8, nb = rr % 8;
                transpose_item(a.pool_w + ((size_t)l * 4 + gidx) * 65536, 256, (bf16_t*)(wl + WO_POOL) + (size_t)gidx * 65536, 256, 64 * kb, 32 * nb, 32 * nb, scr, lane); }
        }
        for (int m = gw; m < T; m += NGW) rms_row_to_bf16(a.x + (size_t)m * DM, a.pre_mix_g, Hb + (size_t)m * DM, lane);
    }
    END_PH();

    for (int l = 0; l < DEPTH; ++l) {
        unsigned char* wl = ws + WS_W + (size_t)l * W_LAYER;
        const bf16_t* Win = (const bf16_t*)(wl + WO_IN); const bf16_t* Wo = (const bf16_t*)(wl + WO_O); const bf16_t* Wup = (const bf16_t*)(wl + WO_UP);
        const bf16_t* Wdn = (const bf16_t*)(wl + WO_DOWN); const bf16_t* Wpl = (const bf16_t*)(wl + WO_POOL);
        if (IN_PH()) {
            { pg8::Gemm g{Hb, Win, DM, DM, DM, 0}; pg8::StaticOrder S; S.init(T, NQKU, G, bx); pg8::EpiStore E{QKU, NQKU, 0, nullptr};
              pg8::gemm_phase<pg8::EpiStore, pg8::StaticOrder, true>(lds, g, S, E); }
            { pg8::Gemm g{Win + (size_t)NQKU * DM, Hb, DM, DM, DM, 0}; pg8::StaticOrder S; S.init(AW, T, G, bx); pg8::EpiStore E{VT, T, 0, nullptr};
              pg8::gemm_phase<pg8::EpiStore, pg8::StaticOrder, true>(lds, g, S, E); }
        }
        END_PH();
        if (IN_PH()) {
            attn_phase(lds, QKU, VT, CC, a.rel_bias + (size_t)l * NH * NREL, vcu, G);
            OPAQUE_TID();
            for (int item = bx * 512 + tid; item < (T / 32) * 128; item += G * 512) {
                const int cv = item & 127, tb = item >> 7; const int c0 = cv * 8, grp = cv >> 5, w = 2 << grp;
                const int r0 = tb * 32, s0 = r0 % SEQ;
                const bf16_t* up = QKU + 2048 + c0;
                float sum[8];
#pragma unroll
                for (int e = 0; e < 8; ++e) sum[e] = 0.f;
                for (int i = 1; i < w; ++i) if (s0 - i >= 0) { const u32x4 q = *(const u32x4*)(up + (size_t)(r0 - i) * NQKU);
                    sum[0] += bf_lo(q.x); sum[1] += bf_hi(q.x); sum[2] += bf_lo(q.y); sum[3] += bf_hi(q.y); sum[4] += bf_lo(q.z); sum[5] += bf_hi(q.z); sum[6] += bf_lo(q.w); sum[7] += bf_hi(q.w); }
                for (int i = 0; i < 32; ++i) {
                    const int s = s0 + i; const u32x4 q = *(const u32x4*)(up + (size_t)(r0 + i) * NQKU);
                    const float cu[8] = {bf_lo(q.x), bf_hi(q.x), bf_lo(q.y), bf_hi(q.y), bf_lo(q.z), bf_hi(q.z), bf_lo(q.w), bf_hi(q.w)};
                    const float ic = 1.0f / (float)((s + 1) < w ? (s + 1) : w);
                    float o[8];
#pragma unroll
                    for (int e = 0; e < 8; ++e) { sum[e] += cu[e]; o[e] = sum[e] * ic - cu[e]; }
                    u32x4 ow; ow.x = cvt_pk_bf16(o[0], o[1]); ow.y = cvt_pk_bf16(o[2], o[3]); ow.z = cvt_pk_bf16(o[4], o[5]); ow.w = cvt_pk_bf16(o[6], o[7]);
                    *(u32x4*)(PL + (size_t)(r0 + i) * PWD + c0) = ow;
                    if (s - w + 1 >= 0) { const u32x4 p = *(const u32x4*)(up + (size_t)(r0 + i - w + 1) * NQKU);
                        sum[0] -= bf_lo(p.x); sum[1] -= bf_hi(p.x); sum[2] -= bf_lo(p.y); sum[3] -= bf_hi(p.y); sum[4] -= bf_lo(p.z); sum[5] -= bf_hi(p.z); sum[6] -= bf_lo(p.w); sum[7] -= bf_hi(p.w); }
                }
            }
        }
        END_PH();
        if (IN_PH()) {
            pg8::Gemm g{PL, Wpl, 256, PWD, 256, 256}; pg8::StaticOrder S; S.init(T, PWD, G, bx); pg8::EpiStore E{CC, DM, AW, a.pool_scale + (size_t)l * PWD};
            pg8::gemm_phase<pg8::EpiStore, pg8::StaticOrder, true>(lds, g, S, E);
        }
        END_PH();
        if (IN_PH()) {
            pg8::Gemm g{CC, Wo, DM, DM, DM, 0}; pg8::StaticOrder S; S.init(T, DM, G, bx); pg8::EpiStore E{MY, DM, 0, nullptr};
            pg8::gemm_phase<pg8::EpiStore, pg8::StaticOrder, true>(lds, g, S, E);
        }
        END_PH();
        if (IN_PH()) {
            OPAQUE_TID();
            const float* xin = (l == 0) ? a.x : a.out;
            for (int m = gw; m < T; m += NGW) res_norm_row(MY + (size_t)m * DM, xin + (size_t)m * DM, a.out + (size_t)m * DM, a.post_mix_g + (size_t)l * DM, a.pre_ffn_g + (size_t)l * DM, Hb + (size_t)m * DM, lane);
        }
        END_PH();
        if (IN_PH()) {
            pg8::Gemm g{Hb, Wup, DM, DM, DM, 0}; pg8::StaticOrder S; S.init(T, FF2, G, bx);
            pg8::EpiUpConv E{Gb, a.conv_w + (size_t)l * 3 * FF2, a.conv_b + (size_t)l * FF2, HALO, lds + XCH_OFF};
            pg8::gemm_phase<pg8::EpiUpConv, pg8::StaticOrder, true>(lds, g, S, E);
        }
        END_PH();
        if (IN_PH()) {
            OPAQUE_TID();
            const float* cw = a.conv_w + (size_t)l * 3 * FF2; const float* cb = a.conv_b + (size_t)l * FF2;
            for (int item = bx * 512 + tid; item < 128 * 2 * FF; item += G * 512) {
                const int c = item % FF, rr = (item / FF) & 1, pm = item / (2 * FF);
                float o2[2];
#pragma unroll
                for (int hf = 0; hf < 2; ++hf) { const int oc = hf * FF + c;
                    const float* hc = HALO + (size_t)pm * 4 * FF2 + oc; const float* hp = HALO + (size_t)(pm - 1) * 4 * FF2 + oc;
                    const bool first = (pm % 64) == 0;
                    const float r254 = first ? 0.f : hp[2 * FF2], r255 = first ? 0.f : hp[3 * FF2], r0v = hc[0], r1v = hc[FF2];
                    const float p2 = rr == 0 ? r254 : r255, p1 = rr == 0 ? r255 : r0v, cu = rr == 0 ? r0v : r1v;
                    o2[hf] = cb[oc] + cw[oc] * p2 + cw[FF2 + oc] * p1 + cw[2 * FF2 + oc] * cu; }
                const float o = pg8::gelu_tanh(o2[0]) * o2[1];
                Gb[(size_t)(pm * 256 + rr) * FF + c] = (bf16_t)f2bf(o);
            }
        }
        END_PH();
        if (IN_PH()) {
            pg8::Gemm g{Gb, Wdn, FF, FF, FF, 0}; pg8::StaticOrder S; S.init(T, DM, G, bx); pg8::EpiStore E{MY, DM, 0, nullptr};
            pg8::gemm_phase<pg8::EpiStore, pg8::StaticOrder, true>(lds, g, S, E);
        }
        END_PH();
        if (IN_PH()) {
            OPAQUE_TID();
            const bool lastl = (l == DEPTH - 1);
            for (int m = gw; m < T; m += NGW) res_norm_row(MY + (size_t)m * DM, a.out + (size_t)m * DM, a.out + (size_t)m * DM, a.post_ffn_g + (size_t)l * DM,
                                                            lastl ? nullptr : a.pre_mix_g + (size_t)(l + 1) * DM, lastl ? nullptr : Hb + (size_t)m * DM, lane);
        }
        END_PH();
    }
#undef IN_PH
#undef END_PH
}

extern "C" void kernel_launch(void* const* d_in, const int* in_sizes, int n_in, void* d_out, int out_size, void* d_ws, size_t ws_size, hipStream_t stream) {
    static int grid = 0;
    if (grid == 0) {
        if (n_in != 14 || out_size != T * DM || ws_size < WS_END) { fprintf(stderr, "kernel_launch: unexpected problem (n_in %d out %d ws %zu)\n", n_in, out_size, ws_size); grid = -1; return; }
        int dev = 0, cus = 0, per_cu = 0;
        hipGetDevice(&dev); hipDeviceGetAttribute(&cus, hipDeviceAttributeMultiprocessorCount, dev);
        hipFuncSetAttribute((const void*)fwd_megakernel, hipFuncAttributeMaxDynamicSharedMemorySize, LDS_BYTES);
        hipOccupancyMaxActiveBlocksPerMultiprocessor(&per_cu, (const void*)fwd_megakernel, 512, LDS_BYTES);
        (void)hipGetLastError();
        if (per_cu < 1) { fprintf(stderr, "kernel_launch: occupancy query says %d blocks per CU\n", per_cu); per_cu = 1; }
        grid = cus;
    }
    if (grid < 0) return;
    Args a{};
    a.x = (const float*)d_in[0]; a.pre_mix_g = (const float*)d_in[1]; a.w_in = (const float*)d_in[2]; a.rel_bias = (const float*)d_in[3]; a.pool_w = (const float*)d_in[4];
    a.pool_scale = (const float*)d_in[5]; a.w_o = (const float*)d_in[6]; a.post_mix_g = (const float*)d_in[7]; a.pre_ffn_g = (const float*)d_in[8]; a.w_up = (const float*)d_in[9];
    a.conv_w = (const float*)d_in[10]; a.conv_b = (const float*)d_in[11]; a.w_down = (const float*)d_in[12]; a.post_ffn_g = (const float*)d_in[13];
    a.out = (float*)d_out; a.ws = (unsigned char*)d_ws; a.pad = 0;
#if MK_COOP
    a.ph_lo = 0; a.ph_hi = N_PHASES; a.coop = 1;
    void* args[] = {&a};
    hipError_t e = hipLaunchCooperativeKernel((const void*)fwd_megakernel, dim3(grid), dim3(512), args, LDS_BYTES, stream);
    if (e != hipSuccess) fprintf(stderr, "cooperative launch failed: %s (grid %d)\n", hipGetErrorString(e), grid);
#else
    for (int p = 0; p < N_PHASES; ++p) { a.ph_lo = p; a.ph_hi = p + 1; a.coop = 0; hipLaunchKernelGGL(fwd_megakernel, dim3(grid), dim3(512), LDS_BYTES, stream, a); }
#endif
}
```
